# Optimizing an MI355X kernel written in HIP

```python
import jax, jax.numpy as jnp
from jax import lax
import numpy as np

D_MODEL = 1024
BATCH = 8
SEQ = 4096
DEPTH = 1

RW_HEAD_DIM = 64
RW_WIDTH = D_MODEL // 2
RW_HEADS = RW_WIDTH // RW_HEAD_DIM
RW_DECAY_LORA = 64
RW_AAA_LORA = 64
RW_GATE_LORA = 128
RW_COLS = 3 * RW_WIDTH + RW_DECAY_LORA + RW_AAA_LORA + RW_GATE_LORA
RW_LNX_EPS = 64e-5
GM_WIDTH = D_MODEL // 2
GM_GROUP_DIM = 64
GM_GROUPS = GM_WIDTH // GM_GROUP_DIM
GM_CHUNK = 128
N_BRANCH = 2
IN_COLS = RW_COLS + 2 * GM_WIDTH + N_BRANCH * D_MODEL
N_EXPERTS = 256
TOP_K = 8
EXPERT_DIM = D_MODEL // 4
SHARED_DIM = D_MODEL // 4
ROUTED_SCALE = 2.5
MOE_BLOCK = 128
NORM_EPS = 1e-6
LN_EPS = 1e-5

kernel_name = 'hybrid_rwkv7_gmlp_moe_adaln'


def rmsnorm(x, g):
    xf = x.astype(jnp.float32)
    y = xf * lax.rsqrt(jnp.mean(xf * xf, -1, keepdims=True) + NORM_EPS)
    return (y * g.astype(jnp.float32)).astype(x.dtype)


def token_shift(p, mu):
    prev = jnp.pad(p, ((0, 0), (1, 0), (0, 0)))[:, :-1]
    return p + (prev - p) * mu


def wkv7_scan(r, w, k, v, a, b):
    Bb, Ss, H, N = r.shape

    def step(st, inp):
        r_t, w_t, k_t, v_t, a_t, b_t = inp
        sa = jnp.einsum('bhij,bhj->bhi', st, a_t)
        st = st * w_t[:, :, None, :] + sa[..., None] * b_t[:, :, None, :] + v_t[..., None] * k_t[:, :, None, :]
        return st, jnp.einsum('bhij,bhj->bhi', st, r_t)

    xs = tuple(jnp.moveaxis(t, 1, 0) for t in (r, w, k, v, a, b))
    _, ys = lax.scan(step, jnp.zeros((Bb, H, N, N), jnp.float32), xs)
    return jnp.moveaxis(ys, 0, 1)


def rwkv7_branch(p_rw, mu, w0, w2, a0, a2, g2, k_k, k_a, r_k, lnx_g, lnx_b):
    f32 = jnp.float32
    Bb, Ss, _ = p_rw.shape
    C = RW_WIDTH
    xs = token_shift(p_rw.astype(f32), mu)
    r = xs[..., :C]
    k = xs[..., C:2 * C]
    v = xs[..., 2 * C:3 * C]
    o = 3 * C
    xw = xs[..., o:o + RW_DECAY_LORA]
    o += RW_DECAY_LORA
    xa = xs[..., o:o + RW_AAA_LORA]
    o += RW_AAA_LORA
    xg = xs[..., o:o + RW_GATE_LORA]
    w_log = -jax.nn.softplus(-(w0 + jnp.tanh(xw) @ w2)) - 0.5
    decay = jnp.exp(-jnp.exp(w_log))
    a = jax.nn.sigmoid(a0 + xa @ a2)
    g = jax.nn.sigmoid(xg) @ g2

    def heads(t):
        return t.reshape(Bb, Ss, RW_HEADS, RW_HEAD_DIM)

    kk = heads(k * k_k)
    kk = kk * lax.rsqrt(jnp.maximum(jnp.sum(kk * kk, -1, keepdims=True), 1e-24))
    k = k * (1.0 + (a - 1.0) * k_a)
    rh, kh, vh, ah = heads(r), heads(k), heads(v), heads(a)
    y = wkv7_scan(rh, heads(decay), kh, vh, -kk, kk * ah)
    m = jnp.mean(y, -1, keepdims=True)
    var = jnp.mean(jnp.square(y - m), -1, keepdims=True)
    y = (y - m) * lax.rsqrt(var + RW_LNX_EPS) * lnx_g.reshape(RW_HEADS, RW_HEAD_DIM) \
        + lnx_b.reshape(RW_HEADS, RW_HEAD_DIM)
    y = y + jnp.sum(rh * kh * r_k, -1, keepdims=True) * vh
    return y.reshape(Bb, Ss, C) * g


def gmlp_branch(p_gm, ln_g, ln_b, w_s, b_s):
    f32 = jnp.float32
    Bb, Ss, _ = p_gm.shape
    nC = Ss // GM_CHUNK
    z = jax.nn.gelu(p_gm.astype(f32))
    u = z[..., :GM_WIDTH].reshape(Bb, nC, GM_CHUNK, GM_GROUPS, GM_GROUP_DIM)
    v = z[..., GM_WIDTH:].reshape(Bb, nC, GM_CHUNK, GM_GROUPS, GM_GROUP_DIM)
    m = jnp.mean(v, -1, keepdims=True)
    var = jnp.mean(jnp.square(v - m), -1, keepdims=True)
    vn = (v - m) * lax.rsqrt(var + LN_EPS) * ln_g + ln_b
    ws = w_s * jnp.tril(jnp.ones((GM_CHUNK, GM_CHUNK), f32))
    sv = jnp.einsum('gts,bnsgc->bntgc', ws, vn) + jnp.swapaxes(b_s, 0, 1)[:, :, None]
    return (u * sv).reshape(Bb, Ss, GM_WIDTH)


def swiglu(x, wg, wu, wd):
    return (jax.nn.silu(x @ wg) * (x @ wu)) @ wd


def moe(h, router_w, router_b, w_gate, w_up, w_down, s_gate, s_up, s_down):
    f32 = jnp.float32
    Bb, Ss, D = h.shape
    N = Bb * Ss
    NK = N * TOP_K
    hf = h.reshape(N, D)
    scores = jax.nn.sigmoid((hf @ router_w).astype(f32))
    _, idx = lax.top_k(scores + router_b.astype(f32), TOP_K)
    sel = jnp.take_along_axis(scores, idx, axis=1)
    wts = sel / jnp.sum(sel, -1, keepdims=True) * ROUTED_SCALE
    flat_e = idx.reshape(-1)
    flat_tok = jnp.arange(NK, dtype=jnp.int32) // TOP_K
    flat_w = wts.reshape(-1)
    order = jnp.argsort(flat_e)
    se = flat_e[order]
    counts = jnp.bincount(flat_e, length=N_EXPERTS)
    starts = jnp.cumsum(counts) - counts
    padded = (counts + MOE_BLOCK - 1) // MOE_BLOCK * MOE_BLOCK
    pends = jnp.cumsum(padded)
    pstarts = pends - padded
    dest = pstarts[se] + (jnp.arange(NK, dtype=jnp.int32) - starts[se])
    P = NK + N_EXPERTS * MOE_BLOCK
    nb = P // MOE_BLOCK
    row_tok = jnp.full((P,), N, jnp.int32).at[dest].set(flat_tok[order])
    row_w = jnp.zeros((P,), f32).at[dest].set(flat_w[order])
    block_e = jnp.minimum(jnp.searchsorted(pends, jnp.arange(nb, dtype=jnp.int32) * MOE_BLOCK, side='right'), N_EXPERTS - 1)
    hpad = jnp.concatenate([hf, jnp.zeros((1, D), hf.dtype)], axis=0)

    def body(y, blk):
        tok, wt, e = blk
        xb = hpad[tok]
        ob = swiglu(xb, w_gate[e], w_up[e], w_down[e]) * wt[:, None].astype(xb.dtype)
        return y.at[tok].add(ob.astype(y.dtype)), None

    y, _ = lax.scan(body, jnp.zeros((N + 1, D), hf.dtype),
                    (row_tok.reshape(nb, MOE_BLOCK), row_w.reshape(nb, MOE_BLOCK), block_e))
    out = y[:N] + swiglu(hf, s_gate, s_up, s_down)
    return out.reshape(Bb, Ss, D)


def setup_inputs(seed: int = 0) -> dict:
    key = jax.random.key(seed)
    ks = iter(jax.random.split(key, 48))
    f32 = jnp.float32
    L = DEPTH
    D = D_MODEL

    def nrm(shape, scale):
        return jax.random.normal(next(ks), shape, f32) * scale

    def near_one(shape):
        return 1.0 + 0.1 * jax.random.normal(next(ks), shape, f32)

    return {
        'x': nrm((BATCH, SEQ, D), 1.0),
        'c': nrm((BATCH, D), 1.0),
        'w_ada': nrm((L, D, 6 * D), 0.5 * D ** -0.5),
        'b_ada': nrm((L, 6 * D), 0.02),
        'norm1_g': near_one((L, D)),
        'w_in': nrm((L, D, IN_COLS), D ** -0.5),
        'rw_mu': jax.random.uniform(next(ks), (L, RW_COLS), f32),
        'rw_w0': nrm((L, RW_WIDTH), 0.5) - 0.5,
        'rw_w2': nrm((L, RW_DECAY_LORA, RW_WIDTH), 0.5 * RW_DECAY_LORA ** -0.5),
        'rw_a0': nrm((L, RW_WIDTH), 0.5),
        'rw_a2': nrm((L, RW_AAA_LORA, RW_WIDTH), 0.5 * RW_AAA_LORA ** -0.5),
        'rw_g2': nrm((L, RW_GATE_LORA, RW_WIDTH), RW_GATE_LORA ** -0.5),
        'rw_k_k': near_one((L, RW_WIDTH)),
        'rw_k_a': near_one((L, RW_WIDTH)),
        'rw_r_k': nrm((L, RW_HEADS, RW_HEAD_DIM), 0.1),
        'rw_lnx_g': near_one((L, RW_WIDTH)),
        'rw_lnx_b': nrm((L, RW_WIDTH), 0.02),
        'gm_ln_g': near_one((L, GM_GROUPS, GM_GROUP_DIM)),
        'gm_ln_b': nrm((L, GM_GROUPS, GM_GROUP_DIM), 0.02),
        'gm_w_s': nrm((L, GM_GROUPS, GM_CHUNK, GM_CHUNK), GM_CHUNK ** -0.5),
        'gm_b_s': near_one((L, GM_GROUPS, GM_CHUNK)),
        'w_br_rwkv': nrm((L, RW_WIDTH, D), RW_WIDTH ** -0.5),
        'w_br_gmlp': nrm((L, GM_WIDTH, D), GM_WIDTH ** -0.5),
        'w_out': nrm((L, D, D), D ** -0.5),
        'norm2_g': near_one((L, D)),
        'router_w': nrm((L, D, N_EXPERTS), D ** -0.5),
        'router_b': nrm((L, N_EXPERTS), 0.01),
        'moe_w_gate': nrm((L, N_EXPERTS, D, EXPERT_DIM), D ** -0.5),
        'moe_w_up': nrm((L, N_EXPERTS, D, EXPERT_DIM), D ** -0.5),
        'moe_w_down': nrm((L, N_EXPERTS, EXPERT_DIM, D), EXPERT_DIM ** -0.5),
        'sh_w_gate': nrm((L, D, SHARED_DIM), D ** -0.5),
        'sh_w_up': nrm((L, D, SHARED_DIM), D ** -0.5),
        'sh_w_down': nrm((L, SHARED_DIM, D), SHARED_DIM ** -0.5),
        'final_g': near_one((D,)),
    }


def reference(x, c, w_ada, b_ada, norm1_g, w_in, rw_mu, rw_w0, rw_w2, rw_a0, rw_a2, rw_g2,
              rw_k_k, rw_k_a, rw_r_k, rw_lnx_g, rw_lnx_b, gm_ln_g, gm_ln_b, gm_w_s, gm_b_s,
              w_br_rwkv, w_br_gmlp, w_out, norm2_g, router_w, router_b, moe_w_gate, moe_w_up,
              moe_w_down, sh_w_gate, sh_w_up, sh_w_down, final_g):
    Bb, Ss, D = x.shape
    for l in range(DEPTH):
        mod = (jax.nn.silu(c) @ w_ada[l] + b_ada[l]).reshape(Bb, 6, D)
        sh1, sc1, gt1 = mod[:, 0, None, :], mod[:, 1, None, :], mod[:, 2, None, :]
        sh2, sc2, gt2 = mod[:, 3, None, :], mod[:, 4, None, :], mod[:, 5, None, :]

        h = rmsnorm(x, norm1_g[l]) * (1.0 + sc1) + sh1
        p = h @ w_in[l]
        p_rw = p[..., :RW_COLS]
        p_gm = p[..., RW_COLS:RW_COLS + 2 * GM_WIDTH]
        p_gt = p[..., RW_COLS + 2 * GM_WIDTH:]
        o_rw = rwkv7_branch(p_rw, rw_mu[l], rw_w0[l], rw_w2[l], rw_a0[l], rw_a2[l], rw_g2[l],
                            rw_k_k[l], rw_k_a[l], rw_r_k[l], rw_lnx_g[l], rw_lnx_b[l]).astype(x.dtype)
        o_gm = gmlp_branch(p_gm, gm_ln_g[l], gm_ln_b[l], gm_w_s[l], gm_b_s[l]).astype(x.dtype)
        gates = jax.nn.sigmoid(p_gt.astype(jnp.float32)).astype(x.dtype)
        merged = gates[..., :D] * (o_rw @ w_br_rwkv[l]) + gates[..., D:] * (o_gm @ w_br_gmlp[l])
        x = x + gt1 * (merged @ w_out[l])

        h2 = rmsnorm(x, norm2_g[l]) * (1.0 + sc2) + sh2
        x = x + gt2 * moe(h2, router_w[l], router_b[l], moe_w_gate[l], moe_w_up[l], moe_w_down[l],
                          sh_w_gate[l], sh_w_up[l], sh_w_down[l])
    return rmsnorm(x, final_g)
```

```cpp
#include <hip/hip_runtime.h>
#include <type_traits>
#include <hip/hip_cooperative_groups.h>
#include <cstdio>
#include <cstdint>
namespace cg = cooperative_groups;

typedef unsigned short bf16_t;
__device__ __forceinline__ float bf2f(bf16_t v) { return __uint_as_float((unsigned)v << 16); }
__device__ __forceinline__ bf16_t f2bf(float f) { unsigned u = __float_as_uint(f); return (bf16_t)((u + 0x7fffu + ((u >> 16) & 1u)) >> 16); }

constexpr int NB = 8, SEQ = 4096, D = 1024, NTOK = NB * SEQ;
constexpr int CW = 512;
constexpr int RWC = 1792, INC = 4864, GT_OFF = 2816;
constexpr int NE = 256, TOPK = 8, ED = 256;
constexpr int NPAIR = NTOK * TOPK;
#ifndef PROBE_MASK
#define PROBE_MASK 0
#define PROBE_N 1
#endif
constexpr bool MOE1_F8 = true;
constexpr bool OUT_F8 = true;
constexpr float MRG_SCALE = 32.f;
constexpr bool MRG_F8 = true;
constexpr float ORW_SCALE = 16.f, OGM_SCALE = 8.f;
constexpr bool PG_F8 = true;
constexpr float YS_SCALE = 16.f;
constexpr int NT = 512;
constexpr int LDS_BYTES = 155648;

constexpr size_t MiB = 1u << 20;
constexpr size_t WS_CTL = 0;
constexpr size_t WS_MOD = 1 * MiB;
constexpr size_t WS_BONUS = 2 * MiB;
constexpr size_t WS_TOKE = 3 * MiB;
constexpr size_t WS_TOKW = 4 * MiB;
constexpr size_t WS_TILE = 512 * 1024;
constexpr size_t WS_LORA = 768 * 1024;
constexpr size_t WS_BLKCNT = 5 * MiB;
constexpr size_t WS_TOKLP = 6 * MiB;
constexpr size_t WS_TOKDEST = 7 * MiB;
constexpr size_t WS_ROWTOK = 8 * MiB;
constexpr size_t WS_ROWW = 10 * MiB;
constexpr size_t WS_BK2 = 8 * MiB;
constexpr size_t WS_WTIN = 12 * MiB;
constexpr size_t WS_WTBR = 22 * MiB;
constexpr size_t WS_WTOUT = 24 * MiB;
constexpr size_t WS_WTRS = 26 * MiB;
constexpr size_t WS_WTSHD = 27 * MiB + 512 * 1024;
constexpr size_t WS_WTDN = 28 * MiB;
constexpr size_t WS_WTGU = 156 * MiB;
constexpr size_t WS_YS = 156 * MiB;
constexpr size_t WS_YSH = 844 * MiB;
constexpr size_t WS_X1 = 476 * MiB;
constexpr size_t WS_H2F8 = 972 * MiB;
constexpr size_t WS_ACTP = 668 * MiB;
constexpr size_t WS_SCANV = 437 * MiB;
constexpr size_t OPS_BH = (size_t)(SEQ / 16) * 12800;
constexpr int OPB = 12800;
constexpr size_t WS_H = 412 * MiB;
constexpr size_t WS_O = 476 * MiB;
constexpr size_t WS_P = 540 * MiB;
constexpr size_t WS_Y = 844 * MiB;
constexpr size_t WS_G = 908 * MiB;
constexpr size_t WS_ACTSH = 940 * MiB;
constexpr size_t WS_VN = WS_H;
constexpr size_t WS_ACT = 668 * MiB;
constexpr size_t WS_END = 1024 * MiB;

__device__ __forceinline__ int pk4_fp8(float a, float b, float c, float d) {
    a = __builtin_fminf(__builtin_fmaxf(a, -448.f), 448.f); b = __builtin_fminf(__builtin_fmaxf(b, -448.f), 448.f); c = __builtin_fminf(__builtin_fmaxf(c, -448.f), 448.f); d = __builtin_fminf(__builtin_fmaxf(d, -448.f), 448.f);
    int r = __builtin_amdgcn_cvt_pk_fp8_f32(a, b, 0, false); return __builtin_amdgcn_cvt_pk_fp8_f32(c, d, r, true);
}
struct Params {
    const float* in[34];
    float* out;
    unsigned char* ws;
};

__device__ __forceinline__ unsigned char* ops_ptr(const Params& P, int bh) {
    return bh < 40 ? (unsigned char*)P.out + (size_t)bh * OPS_BH : (bh < 56 ? P.ws + 972 * MiB + (size_t)(bh - 40) * OPS_BH : P.ws + 412 * MiB + (size_t)(bh - 56) * OPS_BH);
}
__device__ __forceinline__ float wave_sum(float v) {
#pragma unroll
    for (int o = 32; o; o >>= 1) v += __shfl_xor(v, o);
    return v;
}
__device__ __forceinline__ float sigmoidf_(float x) { return 1.f / (1.f + expf(-x)); }
__device__ __forceinline__ float siluf_(float x) { return x / (1.f + expf(-x)); }
__device__ __forceinline__ float geluf_(float x) { return 0.5f * x * (1.f + tanhf(0.7978845608028654f * (x + 0.044715f * x * x * x))); }

struct Ctx { long gtid, gthreads; int gwave, nwaves, lane, tid; };

template <int MODE, bool XBF16>
__device__ __forceinline__ void n_norm(const Params& P, const Ctx& c, const void* xin, const float* g, int sh_idx, int sc_idx) {
    typedef float f32x4_ __attribute__((ext_vector_type(4)));
    typedef unsigned u32x2_ __attribute__((ext_vector_type(2)));
    const float* mod = (const float*)(P.ws + WS_MOD);
    bf16_t* H = (bf16_t*)(P.ws + WS_H);
    typedef typename std::conditional<XBF16, u32x2_, f32x4_>::type raw_t;
    raw_t nx[4];
#pragma unroll
    for (int i = 0; i < 4; ++i) { if (XBF16) nx[i] = *(const raw_t*)((const bf16_t*)xin + (size_t)c.gwave * D + 4 * c.lane + 256 * i); else nx[i] = *(const raw_t*)((const float*)xin + (size_t)c.gwave * D + 4 * c.lane + 256 * i); }
    for (int m = c.gwave; m < NTOK; m += c.nwaves) {
        f32x4_ v[4]; float ss = 0.f;
        raw_t cur[4];
#pragma unroll
        for (int i = 0; i < 4; ++i) cur[i] = nx[i];
        if (m + c.nwaves < NTOK) {
#pragma unroll
            for (int i = 0; i < 4; ++i) { if (XBF16) nx[i] = *(const raw_t*)((const bf16_t*)xin + (size_t)(m + c.nwaves) * D + 4 * c.lane + 256 * i); else nx[i] = *(const raw_t*)((const float*)xin + (size_t)(m + c.nwaves) * D + 4 * c.lane + 256 * i); } }
#pragma unroll
        for (int i = 0; i < 4; ++i) {
            if constexpr (XBF16) { const u32x2_ r_ = cur[i]; v[i] = (f32x4_){__uint_as_float(r_[0] << 16), __uint_as_float(r_[0] & 0xffff0000u), __uint_as_float(r_[1] << 16), __uint_as_float(r_[1] & 0xffff0000u)}; }
            else v[i] = cur[i];
            ss += (v[i][0] * v[i][0] + v[i][1] * v[i][1]) + (v[i][2] * v[i][2] + v[i][3] * v[i][3]); }
        ss = wave_sum(ss);
        const float rstd = rsqrtf(ss * (1.f / D) + 1e-6f);
        const float* mb = mod + (size_t)(m / SEQ) * 6 * D;
#pragma unroll
        for (int i = 0; i < 4; ++i) { const int j = 4 * c.lane + 256 * i;
            const f32x4_ gv = *(const f32x4_*)(g + j), scv = *(const f32x4_*)(mb + sc_idx * D + j), shv = *(const f32x4_*)(mb + sh_idx * D + j);
            float hv[4];
#pragma unroll
            for (int q = 0; q < 4; ++q) hv[q] = v[i][q] * rstd * gv[q] * (1.f + scv[q]) + shv[q];
            if (MODE != 2) *(u32x2_*)(H + (size_t)m * D + j) = (u32x2_){(unsigned)f2bf(hv[0]) | ((unsigned)f2bf(hv[1]) << 16), (unsigned)f2bf(hv[2]) | ((unsigned)f2bf(hv[3]) << 16)};
            if (MODE != 0) { const int pk = pk4_fp8(hv[0] * 2.f, hv[1] * 2.f, hv[2] * 2.f, hv[3] * 2.f);
                *(int*)(P.ws + (MODE == 1 ? WS_H2F8 : WS_H) + (size_t)m * D + j) = pk; }
        }
    }
}

#define LAS __attribute__((address_space(3)))
typedef short bf16x8 __attribute__((ext_vector_type(8)));
typedef float f32x4 __attribute__((ext_vector_type(4)));
typedef unsigned u32x4 __attribute__((ext_vector_type(4)));
typedef unsigned u32x2 __attribute__((ext_vector_type(2)));
typedef int i32x8 __attribute__((ext_vector_type(8)));
typedef int i32x4 __attribute__((ext_vector_type(4)));
namespace pg8 {
constexpr int BM = 256, BK = 64, HALF = 128, HTB = HALF * BK * 2, STAGE_BYTES = 8 * HTB, NXCD = 8, WGM = 8;
constexpr unsigned PRE_OFF = STAGE_BYTES + 10 * 2048;
__device__ __forceinline__ int lds_byte(int r, int c) { const int st = (r >> 4) * 2 + (c >> 5), rr = r & 15, cc = c & 31, ob = rr * 64 + cc * 2; return st * 1024 + (ob ^ (((ob >> 9) & 1) << 5)); }
__device__ __forceinline__ void stage_rc(int b, int& R, int& C) { const int st = b / 1024, sb = b % 1024, swz = sb ^ (((sb >> 9) & 1) << 5); R = (st >> 1) * 16 + swz / 64; C = (st & 1) * 32 + (swz % 64) / 2; }
__device__ __forceinline__ int perm32(int rho) { const int n = rho >> 4, i = rho & 15; return 8 * (i >> 2) + 4 * n + (i & 3); }
__device__ __forceinline__ unsigned cvt_pk_bf16(float lo, float hi) { unsigned r; asm volatile("v_cvt_pk_bf16_f32 %0, %1, %2" : "=v"(r) : "v"(lo), "v"(hi)); return r; }

__device__ __forceinline__ int lane_now() { int l_; asm volatile("v_mbcnt_lo_u32_b32 %0, -1, 0\n\tv_mbcnt_hi_u32_b32 %0, -1, %0" : "=v"(l_)); return l_; }
struct Unit { int pm, pn, aux, aux2; };
__device__ __forceinline__ const int* uni_ptr(const int* p) { const unsigned long g_ = (unsigned long)p; return (const int*)(((unsigned long)(unsigned)__builtin_amdgcn_readfirstlane((int)(g_ >> 32)) << 32) | (unsigned long)(unsigned)__builtin_amdgcn_readfirstlane((int)g_)); }
__device__ __forceinline__ int sload1(const int* p) { int v; asm volatile("s_load_dword %0, %1, 0x0\n\ts_waitcnt lgkmcnt(0)" : "=s"(v) : "s"(uni_ptr(p)) : "memory"); return v; }
__device__ __forceinline__ void sload3(const int* p0, const int* p1, const int* p2, int& a, int& b, int& c) {
    asm volatile("s_load_dword %0, %3, 0x0\n\ts_load_dword %1, %4, 0x0\n\ts_load_dword %2, %5, 0x0\n\ts_waitcnt lgkmcnt(0)" : "=&s"(a), "=&s"(b), "=&s"(c) : "s"(uni_ptr(p0)), "s"(uni_ptr(p1)), "s"(uni_ptr(p2)) : "memory"); }

struct DenseSched {
    int nM, nN, nwg, G, c, K; const char* Bt;
    __device__ void init(int M, int N, int K_, int G_, int c_, const void* Bt_, int esz = 2) { nM = M / BM; nN = N / BM; nwg = nM * nN; G = G_; c = c_; K = K_ * esz; Bt = (const char*)Bt_; }
    __device__ __forceinline__ bool next(int i, Unit& u) const {
        const long L = (long)i * G + c; if (L >= nwg) return false;
        int wgid = (int)L; { const int q = nwg / NXCD, r = nwg % NXCD, xcd = wgid % NXCD, off = wgid / NXCD; wgid = (xcd < r ? xcd * (q + 1) : r * (q + 1) + (xcd - r) * q) + off; }
        const int nig = WGM * nN, gid = wgid / nig, fm = gid * WGM, gsz = (nM - fm) < WGM ? (nM - fm) : WGM;
        u.pm = fm + ((wgid % nig) % gsz); u.pn = (wgid % nig) / gsz; u.aux = 0; u.aux2 = 0; return true;
    }
    __device__ __forceinline__ unsigned a_off(const Unit& u, int r) const { return (unsigned)(u.pm * BM + r) * (unsigned)K; }
    __device__ __forceinline__ const char* b_ptr(const Unit& u) const { return Bt + (size_t)u.pn * BM * K; }
};

template <class Epi, class Sched, bool ALIGN_EPI, bool F8 = false>
__device__ __forceinline__ void gemm_phase(LAS unsigned char* lds, const char* Abase, const int K, const Sched& S, const Epi& E, int tid) {
    asm volatile("" : "+v"(tid));
    const int wid = __builtin_amdgcn_readfirstlane(tid >> 6), lane = tid & 63, wr = wid >> 2, wc = wid & 3, fr = lane & 15, fq = lane >> 4;
    const int nt = F8 ? K / 128 : K / BK;
    unsigned voffB_[2];
#pragma unroll
    for (int i = 0; i < 2; ++i) { int sR, sC; stage_rc(tid * 16 + i * 8192, sR, sC); const int Rb = Epi::PERM ? ((sR & ~31) + perm32(sR & 31)) : sR; voffB_[i] = F8 ? (unsigned)(Rb * K + sC * 2) : (unsigned)(Rb * K + sC) * 2u; }
    const size_t kstep = (size_t)(BK * 2);
    const size_t hstepB = (size_t)HALF * K * (F8 ? 1 : 2);
    const unsigned ldsw = (unsigned)wid * 1024u;
    const unsigned slotaddr = (unsigned)(unsigned long)lds + (unsigned)STAGE_BYTES + (unsigned)tid * 4u;
    const unsigned ldsbase = (unsigned)(unsigned long)lds;
    const int lp = F8 ? lds_byte(fr, 32 * (fq >> 1) + 16 * (fq & 1)) + 16 * (fq & 1) : lds_byte(fr, fq * 8);
    const unsigned aU = (unsigned)(unsigned long)lds + (unsigned)wr * 8192u, bU = (unsigned)(unsigned long)lds + (unsigned)wc * 4096u;
    volatile LAS unsigned* myslot = (volatile LAS unsigned*)(lds + STAGE_BYTES) + tid;
    myslot[8 * 512] = voffB_[0]; myslot[9 * 512] = voffB_[1];
    struct VB_ { volatile LAS unsigned* p; __device__ __forceinline__ unsigned operator[](int i) const { return p[(8 + i) * 512]; } } voffB{myslot};
#define PG8_FILL(par, u) do { const int _t = (wid << 6) | lane_now(); _Pragma("unroll") for (int _i = 0; _i < 2; ++_i) { int _R, _C; stage_rc(_t * 16 + _i * 8192, _R, _C); \
        _Pragma("unroll") for (int _h = 0; _h < 2; ++_h) myslot[((par) * 4 + _h * 2 + _i) * 512] = S.a_off(u, _h * HALF + _R) + (unsigned)_C * 2u; } } while (0)
#define PG8_SA(b, h) (((b) * 2 + (h)) * HTB)
#define PG8_SB(b, h) ((4 + (b) * 2 + (h)) * HTB)
#define PG8_STAGE(bufoff, gbase, voff) do { _Pragma("unroll") for (int _i = 0; _i < 2; ++_i) \
        __builtin_amdgcn_global_load_lds((const unsigned*)((const char*)(gbase) + (voff)[_i]), (LAS unsigned*)(lds + (bufoff) + ldsw + _i * 8192), 16, 0, 0); } while (0)
#define PG8_STAGE_A(bufoff, gbase, par, h) do { _Pragma("unroll") for (int _i = 0; _i < 2; ++_i) { const unsigned _o = myslot[((par) * 4 + (h) * 2 + _i) * 512]; \
        __builtin_amdgcn_global_load_lds((const unsigned*)((const char*)(gbase) + _o), (LAS unsigned*)(lds + (bufoff) + ldsw + _i * 8192), 16, 0, 0); } } while (0)
#define PG8_RD(dst, par, e) asm volatile("v_lshl_add_u32 %0, %2, 13, %1\n\tds_read_b32 %0, %0 offset:%3" : "=&v"(dst) : "v"(slotaddr), "s"((unsigned)(par)), "n"((e) * 2048) : "memory")
#define PG8_DMA1(ldsaddr, gbase, off) asm volatile("s_mov_b32 m0, %0\n\ts_nop 0\n\tglobal_load_lds_dwordx4 %1, %2" :: "s"(ldsaddr), "v"(off), "s"(gbase) : "memory", "m0")
#define PG8_STAGE_O(bufoff, gbase, o0, o1) do { const unsigned _la = ldsbase + (unsigned)(bufoff) + ldsw; const unsigned long _g = (unsigned long)(gbase); const char* _gb = (const char*)(((unsigned long)(unsigned)__builtin_amdgcn_readfirstlane((int)(_g >> 32)) << 32) | (unsigned long)(unsigned)__builtin_amdgcn_readfirstlane((int)_g)); PG8_DMA1(_la, _gb, o0); PG8_DMA1(_la + 8192u, _gb, o1); } while (0)
#define PG8_STAGE_B(bufoff, gbase, o0) do { const unsigned _la = ldsbase + (unsigned)(bufoff) + ldsw; const unsigned long _g = (unsigned long)(gbase); const char* _gb = (const char*)(((unsigned long)(unsigned)__builtin_amdgcn_readfirstlane((int)(_g >> 32)) << 32) | (unsigned long)(unsigned)__builtin_amdgcn_readfirstlane((int)_g)); PG8_DMA1(_la, _gb, o0); PG8_DMA1(_la + 8192u, _gb + (hstepB >> 1), o0); } while (0)
#define PG8_LDA(dst, b, h) do { unsigned a0_, a1_; asm volatile("v_add_u32 %0, %1, %2" : "=v"(a0_) : "s"(aU + (unsigned)PG8_SA(b, h)), "v"(lp)); a1_ = a0_; if constexpr (F8) asm volatile("v_xor_b32 %0, 16, %0" : "+v"(a1_)); _Pragma("unroll") for (int m = 0; m < 4; ++m) _Pragma("unroll") for (int k = 0; k < 2; ++k) dst[m][k] = *(const LAS bf16x8*)(unsigned long)((F8 ? (k ? a1_ : a0_) : a0_ + k * 1024) + m * 2048); } while (0)
#define PG8_LDB(dst, b, h) do { unsigned b0_, b1_; asm volatile("v_add_u32 %0, %1, %2" : "=v"(b0_) : "s"(bU + (unsigned)PG8_SB(b, h)), "v"(lp)); b1_ = b0_; if constexpr (F8) asm volatile("v_xor_b32 %0, 16, %0" : "+v"(b1_)); _Pragma("unroll") for (int n = 0; n < 2; ++n) _Pragma("unroll") for (int k = 0; k < 2; ++k) dst[n][k] = *(const LAS bf16x8*)(unsigned long)((F8 ? (k ? b1_ : b0_) : b0_ + k * 1024) + n * 2048); } while (0)
#define PG8_MMA(ai, bj, At, Bt) do { __builtin_amdgcn_s_setprio(1); _Pragma("unroll") for (int m = 0; m < 4; ++m) _Pragma("unroll") for (int n = 0; n < 2; ++n) { \
        if constexpr (F8) { acc[ai][bj][m][n] = __builtin_amdgcn_mfma_scale_f32_16x16x128_f8f6f4( \
                __builtin_shufflevector(__builtin_bit_cast(i32x4, Bt[n][0]), __builtin_bit_cast(i32x4, Bt[n][1]), 0, 1, 2, 3, 4, 5, 6, 7), \
                __builtin_shufflevector(__builtin_bit_cast(i32x4, At[m][0]), __builtin_bit_cast(i32x4, At[m][1]), 0, 1, 2, 3, 4, 5, 6, 7), acc[ai][bj][m][n], 0, 0, 0, Epi::SC_W, 0, Epi::SC_X); } \
        else { _Pragma("unroll") for (int k = 0; k < 2; ++k) acc[ai][bj][m][n] = __builtin_amdgcn_mfma_f32_16x16x32_bf16(Bt[n][k], At[m][k], acc[ai][bj][m][n], 0, 0, 0); } } \
        __builtin_amdgcn_s_setprio(0); } while (0)
#define PG8_WAIT_V(n) asm volatile("s_waitcnt vmcnt(" #n ")" ::: "memory")
#define PG8_WAIT_V2(nst) asm volatile("s_waitcnt vmcnt(%0)" :: "n"(8 + (nst)) : "memory")
#define PG8_WAIT_L(n) asm volatile("s_waitcnt lgkmcnt(" #n ")" ::: "memory")
#define PG8_BAR __builtin_amdgcn_s_barrier()
#define PG8_SCHED __builtin_amdgcn_sched_barrier(0)
    Unit cur, nxt; int ui = 0, p3 = 0;
    if (!S.next(0, cur)) return;
    f32x4 acc[2][2][4][2];
#pragma unroll
    for (int a = 0; a < 2; ++a)
#pragma unroll
        for (int b = 0; b < 2; ++b)
#pragma unroll
            for (int m = 0; m < 4; ++m)
#pragma unroll
                for (int n = 0; n < 2; ++n) acc[a][b][m][n] = (f32x4){0.f, 0.f, 0.f, 0.f};
    bf16x8 At[4][2], B0[2][2], B1[2][2];
    PG8_FILL(0, cur);
    if constexpr (Epi::HAS_PRE) E.pre(cur.pm, ldsbase + PRE_OFF, wid);
    const char* cB = S.b_ptr(cur);
    PG8_STAGE(PG8_SB(0, 0), cB, voffB); PG8_STAGE(PG8_SB(0, 1), cB + hstepB, voffB); PG8_STAGE_A(PG8_SA(0, 0), Abase, 0, 0); PG8_STAGE_A(PG8_SA(0, 1), Abase, 0, 1);
    if (wr == 1) PG8_BAR;
    PG8_WAIT_V(2); PG8_BAR;
    PG8_STAGE(PG8_SB(1, 0), cB + kstep, voffB); PG8_STAGE_A(PG8_SA(1, 0), Abase + kstep, 0, 0);
    if constexpr (Epi::NST > 0) PG8_WAIT_V(0); else PG8_WAIT_V(4);
    PG8_BAR;
    for (;;) {
        const bool has_next = S.next(ui + 1, nxt);
        const char* nB = has_next ? S.b_ptr(nxt) : cB;
        const int pc = ui & 1, pn_ = has_next ? (pc ^ 1) : pc;
        const int n3 = (p3 == 2) ? 0 : p3 + 1;
        if (has_next) PG8_FILL(pc ^ 1, nxt);
        if constexpr (Epi::HAS_PRE) E.pre(has_next ? nxt.pm : cur.pm, ldsbase + PRE_OFF + (unsigned)n3 * 1024u, wid);
#define PG8_KITER(t, WAITR) do { \
            const bool last = (t == nt - 2); \
            unsigned tk = (unsigned)t * (unsigned)kstep; asm volatile("" : "+s"(tk)); \
            const char* a1 = Abase + tk + kstep; const char* b1 = cB + tk + kstep; \
            const char* a2 = last ? Abase : Abase + tk + 2 * kstep; const char* b2 = last ? nB : cB + tk + 2 * kstep; \
            const char* a3 = a2 + kstep; const char* b3 = b2 + kstep; \
            const int p2 = last ? pn_ : pc; \
            if constexpr (Epi::HAS_MID) { if (t == nt / 2) { Unit um = cur; asm volatile("" : "+v"(um.pm), "+v"(um.pn)); um.pm = __builtin_amdgcn_readfirstlane(um.pm); um.pn = __builtin_amdgcn_readfirstlane(um.pn); const int l2_ = lane_now(); E.mid(acc, um, wr, wc, l2_ & 15, l2_ >> 4); } } \
            { unsigned ob0, oa0, oa1; PG8_RD(ob0, 0, 8); PG8_RD(oa0, pc, 2); PG8_RD(oa1, pc, 3); \
              PG8_LDB(B0, 0, 0); PG8_LDB(B1, 0, 1); PG8_SCHED; PG8_LDA(At, 0, 0); PG8_SCHED; PG8_WAIT_L(15); PG8_STAGE_B(PG8_SB(1, 1), b1 + hstepB, ob0); PG8_STAGE_O(PG8_SA(1, 1), a1, oa0, oa1); } \
            WAITR; PG8_WAIT_L(0); PG8_BAR; PG8_MMA(0, 0, At, B0); PG8_MMA(0, 1, At, B1); PG8_BAR; PG8_SCHED; \
            { unsigned ob0, oa0, oa1; PG8_RD(ob0, 0, 8); PG8_RD(oa0, p2, 0); PG8_RD(oa1, p2, 1); \
              PG8_LDA(At, 0, 1); PG8_SCHED; PG8_WAIT_L(8); PG8_STAGE_B(PG8_SB(0, 0), b2, ob0); PG8_STAGE_O(PG8_SA(0, 0), a2, oa0, oa1); } \
            PG8_WAIT_V(6); PG8_WAIT_L(0); PG8_BAR; PG8_MMA(1, 0, At, B0); PG8_MMA(1, 1, At, B1); PG8_BAR; PG8_SCHED; \
            { unsigned ob0, oa0, oa1; PG8_RD(ob0, 0, 8); PG8_RD(oa0, p2, 2); PG8_RD(oa1, p2, 3); \
              PG8_LDB(B0, 1, 0); PG8_LDB(B1, 1, 1); PG8_SCHED; PG8_LDA(At, 1, 0); PG8_SCHED; PG8_WAIT_L(15); PG8_STAGE_B(PG8_SB(0, 1), b2 + hstepB, ob0); PG8_STAGE_O(PG8_SA(0, 1), a2, oa0, oa1); } \
            PG8_WAIT_V(8); PG8_WAIT_L(0); PG8_BAR; PG8_MMA(0, 0, At, B0); PG8_MMA(0, 1, At, B1); PG8_BAR; PG8_SCHED; \
            { unsigned ob0, oa0, oa1; PG8_RD(ob0, 0, 8); PG8_RD(oa0, p2, 0); PG8_RD(oa1, p2, 1); \
              PG8_LDA(At, 1, 1); PG8_SCHED; PG8_WAIT_L(8); PG8_STAGE_B(PG8_SB(1, 0), b3, ob0); PG8_STAGE_O(PG8_SA(1, 0), a3, oa0, oa1); } \
            PG8_WAIT_V(6); PG8_WAIT_L(0); PG8_BAR; PG8_MMA(1, 0, At, B0); PG8_MMA(1, 1, At, B1); PG8_BAR; PG8_SCHED; \
        } while (0)
        if constexpr (Epi::NST > 0) {
            PG8_KITER(0, PG8_WAIT_V2(Epi::NST));
#pragma unroll 1
            for (int t = 2; t < nt; t += 2) PG8_KITER(t, PG8_WAIT_V(8));
        } else {
#pragma unroll 1
            for (int t = 0; t < nt; t += 2) PG8_KITER(t, PG8_WAIT_V(8));
        }
#undef PG8_KITER
#pragma unroll
        for (int a = 0; a < 2; ++a)
#pragma unroll
            for (int b = 0; b < 2; ++b)
#pragma unroll
                for (int m = 0; m < 4; ++m) asm volatile("" : "+v"(acc[a][b][m][0]), "+v"(acc[a][b][m][1]));
        if constexpr (ALIGN_EPI) { if (wr == 0) PG8_BAR; }
        {
            Unit ue = cur; asm volatile("" : "+v"(ue.pm), "+v"(ue.pn), "+v"(ue.aux), "+v"(ue.aux2));
            ue.pm = __builtin_amdgcn_readfirstlane(ue.pm); ue.pn = __builtin_amdgcn_readfirstlane(ue.pn); ue.aux = __builtin_amdgcn_readfirstlane(ue.aux); ue.aux2 = __builtin_amdgcn_readfirstlane(ue.aux2);
            const int l2_ = lane_now();
            if constexpr (Epi::HAS_PRE) E(acc, ue, wr, wc, l2_ & 15, l2_ >> 4, ldsbase + PRE_OFF + (unsigned)p3 * 1024u); else E(acc, ue, wr, wc, l2_ & 15, l2_ >> 4);
        }
        if (!has_next) break;
#pragma unroll
        for (int a = 0; a < 2; ++a)
#pragma unroll
            for (int b = 0; b < 2; ++b)
#pragma unroll
                for (int m = 0; m < 4; ++m)
#pragma unroll
                    for (int n = 0; n < 2; ++n) acc[a][b][m][n] = (f32x4){0.f, 0.f, 0.f, 0.f};
        cur = nxt; cB = nB; ++ui; p3 = n3;
        if constexpr (ALIGN_EPI) { if (wr == 1) PG8_BAR; }
    }
    PG8_WAIT_V(0);
    if constexpr (!ALIGN_EPI) { if (wr == 0) PG8_BAR; }
    PG8_BAR;
#undef PG8_FILL
#undef PG8_RD
#undef PG8_STAGE_O
#undef PG8_STAGE_B
#undef PG8_DMA1
#undef PG8_STAGE_A
#undef PG8_SA
#undef PG8_SB
#undef PG8_STAGE
#undef PG8_LDA
#undef PG8_LDB
#undef PG8_MMA
#undef PG8_WAIT_V
#undef PG8_WAIT_V2
#undef PG8_WAIT_L
#undef PG8_BAR
#undef PG8_SCHED
}

struct EpiP {
    static constexpr int SC_W = 0x7f7f7f7f, SC_X = 0x7f7f7f7f;
    static constexpr bool PERM = true, HAS_MID = false, HAS_PRE = false; static constexpr int NST = 16;
    bf16_t* O; int ldc;
    __device__ __forceinline__ void operator()(const f32x4 (&acc)[2][2][4][2], const Unit& u, int wr, int wc, int fr, int fq) const {
        const int row0 = u.pm * BM + wr * 64 + fr, col0 = u.pn * BM + wc * 32 + 8 * fq;
#pragma unroll
        for (int ai = 0; ai < 2; ++ai)
#pragma unroll
            for (int m = 0; m < 4; ++m) { bf16_t* rowp = O + (size_t)(row0 + ai * HALF + m * 16) * ldc + col0;
#pragma unroll
                for (int bj = 0; bj < 2; ++bj) { f32x4 v0 = acc[ai][bj][m][0] * (PG_F8 ? 0.0078125f : 1.f), v1 = acc[ai][bj][m][1] * (PG_F8 ? 0.0078125f : 1.f);
                    if (u.pn * BM >= GT_OFF) {
#pragma unroll
                        for (int q = 0; q < 4; ++q) { v0[q] = __builtin_amdgcn_rcpf(1.f + __expf(-v0[q])); v1[q] = __builtin_amdgcn_rcpf(1.f + __expf(-v1[q])); } }
                    u32x4 w; w.x = cvt_pk_bf16(v0[0], v0[1]); w.y = cvt_pk_bf16(v0[2], v0[3]); w.z = cvt_pk_bf16(v1[0], v1[1]); w.w = cvt_pk_bf16(v1[2], v1[3]);
                    *(u32x4*)(rowp + bj * HALF) = w; } }
    }
};
}

__device__ __forceinline__ unsigned pk2(float lo, float hi) { return (unsigned)f2bf(lo) | ((unsigned)f2bf(hi) << 16); }
__device__ __forceinline__ void transpose_item(const float* W, int N, bf16_t* WT, int ldt, LAS float* scr, int k0s, int k0d, int n0, int row0, int lane) {
#pragma unroll 8
    for (int i = 0; i < 32; ++i) { const int kk = 2 * i + (lane >> 5); scr[kk * 33 + (lane & 31)] = W[(size_t)(k0s + kk) * N + n0 + (lane & 31)]; }
    asm volatile("s_waitcnt lgkmcnt(0)" ::: "memory");
    const int c = lane & 7;
#pragma unroll
    for (int j = 0; j < 4; ++j) { const int n = (lane >> 3) + 8 * j; const LAS float* s = scr + (8 * c) * 33 + n;
        u32x4 o; o.x = pk2(s[0 * 33], s[1 * 33]); o.y = pk2(s[2 * 33], s[3 * 33]); o.z = pk2(s[4 * 33], s[5 * 33]); o.w = pk2(s[6 * 33], s[7 * 33]);
        *(u32x4*)(WT + (size_t)(row0 + n) * ldt + k0d + 8 * c) = o; }
    asm volatile("s_waitcnt lgkmcnt(0)" ::: "memory");
}
__device__ __forceinline__ void transpose_item_f8(const float* W, int N, unsigned char* WT, int ldt, LAS float* scr, int k0s, int k0d, int n0, int row0, int lane, float scale) {
#pragma unroll 8
    for (int i = 0; i < 32; ++i) { const int kk = 2 * i + (lane >> 5); scr[kk * 33 + (lane & 31)] = W[(size_t)(k0s + kk) * N + n0 + (lane & 31)] * scale; }
    asm volatile("s_waitcnt lgkmcnt(0)" ::: "memory");
    const int c = lane & 7;
#pragma unroll
    for (int j = 0; j < 4; ++j) { const int n = (lane >> 3) + 8 * j; const LAS float* s = scr + (8 * c) * 33 + n;
        const int lo = pk4_fp8(s[0 * 33], s[1 * 33], s[2 * 33], s[3 * 33]), hi = pk4_fp8(s[4 * 33], s[5 * 33], s[6 * 33], s[7 * 33]);
        *(u32x2*)(WT + (size_t)(row0 + n) * ldt + k0d + 8 * c) = (u32x2){(unsigned)lo, (unsigned)hi}; }
    asm volatile("s_waitcnt lgkmcnt(0)" ::: "memory");
}
__device__ __forceinline__ void transpose_small(const Params& P, LAS float* scr, const Ctx& c) {
    bf16_t* WTIN = (bf16_t*)(P.ws + WS_WTIN); bf16_t* WTBR = (bf16_t*)(P.ws + WS_WTBR); bf16_t* WTOUT = (bf16_t*)(P.ws + WS_WTOUT); bf16_t* WTRS = (bf16_t*)(P.ws + WS_WTRS); bf16_t* WTSHD = (bf16_t*)(P.ws + WS_WTSHD);
    constexpr int I_IN = 16 * 152, I_BR = 8 * 32, I_OUT = 16 * 32, I_R = 16 * 8, I_SD = 4 * 32, I_L = 16;
    constexpr int TOTAL = I_IN + 2 * I_BR + I_OUT + 3 * I_R + I_SD + 4 * I_L;
    bf16_t* W2T = (bf16_t*)(P.ws + WS_LORA); bf16_t* A2T = W2T + 512 * 64; bf16_t* G2T = A2T + 512 * 64;
    for (int it = c.gwave; it < TOTAL; it += c.nwaves) {
        int r = it;
        if (r < I_IN) { const int kb = r / 152, nb = r % 152;
            if (PG_F8) transpose_item_f8(P.in[5], INC, (unsigned char*)WTIN, D, scr, 64 * kb, 64 * kb, 32 * nb, 32 * nb, c.lane, 64.f);
            else transpose_item(P.in[5], INC, WTIN, D, scr, 64 * kb, 64 * kb, 32 * nb, 32 * nb, c.lane);
            continue; } r -= I_IN;
        if (r < I_BR) { const int kb = r / 32, nb = r % 32; if (MRG_F8) transpose_item_f8(P.in[21], D, (unsigned char*)WTBR, D, scr, 64 * kb, 64 * kb, 32 * nb, 32 * nb, c.lane, 64.f); else transpose_item(P.in[21], D, WTBR, D, scr, 64 * kb, 64 * kb, 32 * nb, 32 * nb, c.lane); continue; } r -= I_BR;
        if (r < I_BR) { const int kb = r / 32, nb = r % 32; if (MRG_F8) transpose_item_f8(P.in[22], D, (unsigned char*)WTBR, D, scr, 64 * kb, CW + 64 * kb, 32 * nb, 32 * nb, c.lane, 64.f); else transpose_item(P.in[22], D, WTBR, D, scr, 64 * kb, CW + 64 * kb, 32 * nb, 32 * nb, c.lane); continue; } r -= I_BR;
        if (r < I_OUT) { const int kb = r / 32, nb = r % 32; if (OUT_F8) transpose_item_f8(P.in[23], D, (unsigned char*)WTOUT, D, scr, 64 * kb, 64 * kb, 32 * nb, 32 * nb, c.lane, 64.f); else transpose_item(P.in[23], D, WTOUT, D, scr, 64 * kb, 64 * kb, 32 * nb, 32 * nb, c.lane); continue; } r -= I_OUT;
        if (r < I_R) { const int kb = r / 8, nb = r % 8; transpose_item(P.in[25], NE, WTRS, D, scr, 64 * kb, 64 * kb, 32 * nb, 32 * nb, c.lane); continue; } r -= I_R;
        if (r < I_R) { const int kb = r / 8, nb = r % 8, n0 = 32 * nb; transpose_item_f8(P.in[30], ED, P.ws + WS_WTRS + 512 * 1024, D, scr, 64 * kb, 64 * kb, n0, n0 < 128 ? n0 : 256 + (n0 - 128), c.lane, 64.f); continue; } r -= I_R;
        if (r < I_R) { const int kb = r / 8, nb = r % 8, n0 = 32 * nb; transpose_item_f8(P.in[31], ED, P.ws + WS_WTRS + 512 * 1024, D, scr, 64 * kb, 64 * kb, n0, n0 < 128 ? 128 + n0 : 384 + (n0 - 128), c.lane, 64.f); continue; } r -= I_R;
        if (r < I_SD) { const int kb = r / 32, nb = r % 32; transpose_item(P.in[32], D, WTSHD, ED, scr, 64 * kb, 64 * kb, 32 * nb, 32 * nb, c.lane); continue; } r -= I_SD;
        if (r < I_L) { transpose_item(P.in[8], CW, W2T, 64, scr, 0, 0, 32 * r, 32 * r, c.lane); continue; } r -= I_L;
        if (r < I_L) { transpose_item(P.in[10], CW, A2T, 64, scr, 0, 0, 32 * r, 32 * r, c.lane); continue; } r -= I_L;
        { const int kb = r / 16, nb = r % 16; transpose_item(P.in[11], CW, G2T, 128, scr, 64 * kb, 64 * kb, 32 * nb, 32 * nb, c.lane); }
    }
}
struct MoeItem { const float* W; unsigned char* WT; int N, ldt, k0, n0, row0; float scale; };
__device__ __forceinline__ MoeItem moe_item(const Params& P, int sup, int half) {
    unsigned char* WTGU = P.ws + WS_WTGU; unsigned char* WTDN = P.ws + WS_WTDN;
    const int e = sup / 192; int r = sup % 192; MoeItem m;
    if (r < 128) { const int up = r >> 6; r &= 63; const int kb = 2 * (r / 8) + half, n0 = 32 * (r % 8);
        m.W = (up ? P.in[28] : P.in[27]) + (size_t)e * D * ED; m.N = ED; m.WT = WTGU + (size_t)e * 512 * D; m.ldt = D; m.k0 = 64 * kb; m.n0 = n0; m.row0 = (n0 < 128 ? n0 : 256 + (n0 - 128)) + 128 * up; m.scale = 64.f; }
    else { r -= 128; const int kb = 2 * (r / 32) + half, n0 = 32 * (r % 32);
        m.W = P.in[29] + (size_t)e * ED * D; m.N = D; m.WT = WTDN + (size_t)e * D * ED; m.ldt = ED; m.k0 = 64 * kb; m.n0 = n0; m.row0 = n0; m.scale = 32.f; }
    return m;
}
__device__ __forceinline__ void moe_item_dma(const MoeItem& m, int lane, unsigned buf) {
    const unsigned voff = (unsigned)((lane >> 3) * m.N + 4 * (lane & 7)) * 4u;
    const unsigned long g_ = (unsigned long)(m.W + (size_t)m.k0 * m.N + m.n0);
    const char* gb = (const char*)(((unsigned long)(unsigned)__builtin_amdgcn_readfirstlane((int)(g_ >> 32)) << 32) | (unsigned long)(unsigned)__builtin_amdgcn_readfirstlane((int)g_));
    const unsigned step = (unsigned)__builtin_amdgcn_readfirstlane(m.N) * 32u, b0 = (unsigned)__builtin_amdgcn_readfirstlane((int)buf);
#pragma unroll
    for (int ci = 0; ci < 8; ++ci)
        asm volatile("s_mov_b32 m0, %0\n\ts_nop 0\n\tglobal_load_lds_dwordx4 %1, %2" :: "s"(b0 + (unsigned)ci * 1056u), "v"(voff), "s"(gb + (size_t)ci * step) : "memory", "m0");
}
__device__ __forceinline__ void moe_pair_out(const MoeItem& m, int lane, unsigned bufb) {
    const int c = lane & 7;
#pragma unroll
    for (int j = 0; j < 4; ++j) { const int n = (lane >> 3) + 8 * j;
        const LAS float* s = (const LAS float*)(unsigned long)(bufb + (unsigned)(c >> 2) * 8448u + (unsigned)(2 * (c & 3)) * 1056u + (unsigned)n * 4u);
        float f[16];
#pragma unroll
        for (int i = 0; i < 16; ++i) f[i] = s[(i >> 3) * 264 + (i & 7) * 32] * m.scale;
        u32x4 o; o.x = (unsigned)pk4_fp8(f[0], f[1], f[2], f[3]); o.y = (unsigned)pk4_fp8(f[4], f[5], f[6], f[7]); o.z = (unsigned)pk4_fp8(f[8], f[9], f[10], f[11]); o.w = (unsigned)pk4_fp8(f[12], f[13], f[14], f[15]);
        *(u32x4*)(m.WT + (size_t)(m.row0 + n) * m.ldt + m.k0 + 16 * c) = o; }
    asm volatile("s_waitcnt lgkmcnt(0)" ::: "memory");
}
__device__ __forceinline__ void transpose_moe(const Params& P, LAS unsigned char* lds, int wv, const Ctx& c) {
    static_assert(MOE1_F8, "expert weights are converted to fp8 only");
    const int NSUP = NE * 192;
    const unsigned bufb = (unsigned)(unsigned long)lds + (unsigned)wv * 17408u;
    for (int sup = c.gwave; sup < NSUP; sup += c.nwaves) {
        const MoeItem m0 = moe_item(P, sup, 0), m1 = moe_item(P, sup, 1);
        moe_item_dma(m0, c.lane, bufb); moe_item_dma(m1, c.lane, bufb + 8448u);
        asm volatile("s_waitcnt vmcnt(0)" ::: "memory");
        moe_pair_out(m0, c.lane, bufb);
    }
}

namespace pg8 {
__device__ __forceinline__ float bflo(unsigned u) { return __uint_as_float(u << 16); }
__device__ __forceinline__ float bfhi(unsigned u) { return __uint_as_float(u & 0xffff0000u); }
__device__ __forceinline__ float bfe(const u32x4& v, int e) { const unsigned w = v[e >> 1]; return (e & 1) ? bfhi(w) : bflo(w); }
__device__ __forceinline__ float fsig(float x) { return __builtin_amdgcn_rcpf(1.f + __expf(-x)); }

struct EpiMerge {
    static constexpr int SC_W = 0x7f7f7f7f, SC_X = 0x7f7f7f7f;
    static constexpr bool PERM = true, HAS_MID = true, HAS_PRE = false; static constexpr int NST = 0;
    const bf16_t* Pp; bf16_t* O;
    __device__ __forceinline__ void mid(f32x4 (&acc)[2][2][4][2], const Unit& u, int wr, int wc, int fr, int fq) const {
        const int row0 = u.pm * BM + wr * 64 + fr, col0 = u.pn * BM + wc * 32 + 8 * fq;
#pragma unroll
        for (int ai = 0; ai < 2; ++ai) {
            u32x4 x1[4][2], x2[4][2];
#pragma unroll
            for (int m = 0; m < 4; ++m) { const bf16_t* pr = Pp + (size_t)(row0 + ai * HALF + m * 16) * INC + GT_OFF + col0;
#pragma unroll
                for (int bj = 0; bj < 2; ++bj) { x1[m][bj] = *(const u32x4*)(pr + bj * HALF); x2[m][bj] = *(const u32x4*)(pr + D + bj * HALF); } }
#pragma unroll
            for (int m = 0; m < 4; ++m)
#pragma unroll
                for (int bj = 0; bj < 2; ++bj)
#pragma unroll
                    for (int e = 0; e < 8; ++e) { const float ratio = bfe(x1[m][bj], e) * __builtin_amdgcn_rcpf(bfe(x2[m][bj], e)) * (MRG_F8 ? OGM_SCALE / ORW_SCALE : 1.f); acc[ai][bj][m][e >> 2][e & 3] *= ratio; }
            asm volatile("" ::: "memory");
        }
    }
    __device__ __forceinline__ void operator()(const f32x4 (&acc)[2][2][4][2], const Unit& u, int wr, int wc, int fr, int fq) const {
        const int row0 = u.pm * BM + wr * 64 + fr, col0 = u.pn * BM + wc * 32 + 8 * fq;
#pragma unroll
        for (int ai = 0; ai < 2; ++ai) {
            u32x4 x2[4][2];
#pragma unroll
            for (int m = 0; m < 4; ++m)
#pragma unroll
                for (int bj = 0; bj < 2; ++bj) x2[m][bj] = *(const u32x4*)(Pp + (size_t)(row0 + ai * HALF + m * 16) * INC + GT_OFF + D + col0 + bj * HALF);
#pragma unroll
            for (int m = 0; m < 4; ++m) { const size_t r = (size_t)(row0 + ai * HALF + m * 16);
                if constexpr (OUT_F8) {
                    unsigned pk[2][2];
#pragma unroll
                    for (int bj = 0; bj < 2; ++bj) { float v[8];
#pragma unroll
                        for (int e = 0; e < 8; ++e) v[e] = acc[ai][bj][m][e >> 2][e & 3] * bfe(x2[m][bj], e) * (MRG_F8 ? MRG_SCALE / (OGM_SCALE * 64.f) : MRG_SCALE);
                        pk[bj][0] = (unsigned)pk4_fp8(v[0], v[1], v[2], v[3]); pk[bj][1] = (unsigned)pk4_fp8(v[4], v[5], v[6], v[7]); }
                    const auto sl = __builtin_amdgcn_permlane16_swap(pk[0][0], pk[1][0], false, false);
                    const auto sh = __builtin_amdgcn_permlane16_swap(pk[0][1], pk[1][1], false, false);
                    *(u32x4*)((unsigned char*)O + r * D + (u.pn * BM + wc * 32 + 8 * (fq & ~1) + HALF * (fq & 1))) = (u32x4){sl[0], sh[0], sl[1], sh[1]};
                } else {
#pragma unroll
                for (int bj = 0; bj < 2; ++bj) { float v[8];
#pragma unroll
                    for (int e = 0; e < 8; ++e) v[e] = acc[ai][bj][m][e >> 2][e & 3] * bfe(x2[m][bj], e) * (MRG_F8 ? 1.f / (OGM_SCALE * 64.f) : 1.f);
                    u32x4 w; w.x = cvt_pk_bf16(v[0], v[1]); w.y = cvt_pk_bf16(v[2], v[3]); w.z = cvt_pk_bf16(v[4], v[5]); w.w = cvt_pk_bf16(v[6], v[7]);
                    *(u32x4*)(O + r * D + col0 + bj * HALF) = w; } } }
            asm volatile("" ::: "memory");
        }
    }
};
struct EpiOut {
    static constexpr int SC_W = 0x7f7f7f7f, SC_X = 0x7f7f7f7f;
    static constexpr bool PERM = true, HAS_MID = false, HAS_PRE = false; static constexpr int NST = 0;
    const float* x; const float* mod; bf16_t* out;
    __device__ __forceinline__ void operator()(const f32x4 (&acc)[2][2][4][2], const Unit& u, int wr, int wc, int fr, int fq) const {
        const int row0 = u.pm * BM + wr * 64 + fr, col0 = u.pn * BM + wc * 32 + 8 * fq;
        const float* gt = mod + (size_t)((u.pm * BM) / SEQ) * 6 * D + 2 * D;
#pragma unroll
        for (int bj = 0; bj < 2; ++bj) { const int col = col0 + bj * HALF; const f32x4 g0 = *(const f32x4*)(gt + col) * (OUT_F8 ? 1.f / (MRG_SCALE * 64.f) : 1.f), g1 = *(const f32x4*)(gt + col + 4) * (OUT_F8 ? 1.f / (MRG_SCALE * 64.f) : 1.f);
#pragma unroll
            for (int ai = 0; ai < 2; ++ai)
#pragma unroll
                for (int m = 0; m < 4; ++m) { const size_t o = (size_t)(row0 + ai * HALF + m * 16) * D + col; const f32x4 x0 = *(const f32x4*)(x + o), x1 = *(const f32x4*)(x + o + 4);
                    const f32x4 v0 = x0 + g0 * acc[ai][bj][m][0], v1 = x1 + g1 * acc[ai][bj][m][1];
                    u32x4 w; w.x = cvt_pk_bf16(v0[0], v0[1]); w.y = cvt_pk_bf16(v0[2], v0[3]); w.z = cvt_pk_bf16(v1[0], v1[1]); w.w = cvt_pk_bf16(v1[2], v1[3]);
                    *(u32x4*)(out + o) = w; }
            asm volatile("" ::: "memory"); }
    }
};
struct EpiRouter {
    static constexpr int SC_W = 0x7f7f7f7f, SC_X = 0x7f7f7f7f;
    static constexpr bool PERM = true, HAS_MID = false, HAS_PRE = false; static constexpr int NST = 0;
    float* LG;
    __device__ __forceinline__ void operator()(const f32x4 (&acc)[2][2][4][2], const Unit& u, int wr, int wc, int fr, int fq) const {
        const int row0 = u.pm * BM + wr * 64 + fr;
#pragma unroll
        for (int ai = 0; ai < 2; ++ai)
#pragma unroll
            for (int m = 0; m < 4; ++m) { float* rp = LG + (size_t)(row0 + ai * HALF + m * 16) * NE + wc * 32 + 8 * fq;
#pragma unroll
                for (int bj = 0; bj < 2; ++bj) { *(f32x4*)(rp + bj * HALF) = acc[ai][bj][m][0]; *(f32x4*)(rp + bj * HALF + 4) = acc[ai][bj][m][1]; } }
    }
};
struct EpiShared {
    static constexpr int SC_W = 0x7f7f7f7f, SC_X = 0x7f7f7f7f;
    static constexpr bool PERM = true, HAS_MID = false, HAS_PRE = false; static constexpr int NST = 0;
    bf16_t* ASH;
    __device__ __forceinline__ void operator()(const f32x4 (&acc)[2][2][4][2], const Unit& u, int wr, int wc, int fr, int fq) const {
        const int row0 = u.pm * BM + wr * 64 + fr, j0 = 128 * u.pn + wc * 32 + 8 * fq;
#pragma unroll
        for (int ai = 0; ai < 2; ++ai)
#pragma unroll
            for (int m = 0; m < 4; ++m) { float v[8];
#pragma unroll
                for (int e = 0; e < 8; ++e) { const float g = acc[ai][0][m][e >> 2][e & 3] * 0.0078125f, up = acc[ai][1][m][e >> 2][e & 3] * 0.0078125f; v[e] = g * fsig(g) * up; }
                u32x4 w; w.x = cvt_pk_bf16(v[0], v[1]); w.y = cvt_pk_bf16(v[2], v[3]); w.z = cvt_pk_bf16(v[4], v[5]); w.w = cvt_pk_bf16(v[6], v[7]);
                *(u32x4*)(ASH + (size_t)(row0 + ai * HALF + m * 16) * ED + j0) = w; }
    }
};

struct MoeSched1 {
    const int* row_tok; const int* tile_e; int nunits, G, c; const char* W;
    __device__ __forceinline__ bool next(int i, Unit& u) const { const int L = i * G + c; if (L >= nunits) return false; u.pm = L >> 1; u.pn = L & 1; u.aux = sload1(tile_e + u.pm); u.aux2 = 0; return true; }
    __device__ __forceinline__ unsigned a_off(const Unit& u, int r) const { return (unsigned)row_tok[u.pm * BM + r] * (unsigned)(D * (MOE1_F8 ? 1 : 2)); }
    __device__ __forceinline__ const char* b_ptr(const Unit& u) const { return W + ((size_t)u.aux * 512 + (size_t)u.pn * 256) * (D * (MOE1_F8 ? 1 : 2)); }
};
struct EpiMoe1 {
    static constexpr bool PERM = true, HAS_MID = false, HAS_PRE = false; static constexpr int NST = 0; static constexpr int SC_W = 0x7f7f7f7f, SC_X = 0x7f7f7f7f;
    bf16_t* ACT;
    __device__ __forceinline__ void operator()(const f32x4 (&acc)[2][2][4][2], const Unit& u, int wr, int wc, int fr, int fq) const {
        const int row0 = u.pm * BM + wr * 64 + fr, j0 = 128 * u.pn + wc * 32 + 8 * fq;
#pragma unroll
        for (int ai = 0; ai < 2; ++ai)
#pragma unroll
            for (int m = 0; m < 4; ++m) { float v[8];
#pragma unroll
                for (int e = 0; e < 8; ++e) { const float g = acc[ai][0][m][e >> 2][e & 3] * (MOE1_F8 ? 0.0078125f : 1.f), up = acc[ai][1][m][e >> 2][e & 3] * ((MOE1_F8 ? 0.0078125f : 1.f) * 16.f); v[e] = g * fsig(g) * up; }
                const int lo = pk4_fp8(v[0], v[1], v[2], v[3]), hi = pk4_fp8(v[4], v[5], v[6], v[7]);
                *(u32x2*)((unsigned char*)ACT + (size_t)(row0 + ai * HALF + m * 16) * ED + j0) = (u32x2){(unsigned)lo, (unsigned)hi}; }
    }
};
struct MoeSched2 {
    const int* tile_e; int nunits, G, c; const char* W;
    __device__ __forceinline__ bool next(int i, Unit& u) const { const int L = i * G + c; if (L >= nunits) return false; u.pm = L >> 2; u.pn = L & 3; int cb_, va_; sload3(tile_e + u.pm, tile_e + 2048 + u.pm, tile_e + 4096 + u.pm, u.aux, cb_, va_); u.aux2 = cb_ | (va_ << 20); return true; }
    __device__ __forceinline__ unsigned a_off(const Unit& u, int r) const { return (unsigned)(u.pm * BM + r) * (unsigned)ED; }
    __device__ __forceinline__ const char* b_ptr(const Unit& u) const { return W + ((size_t)u.aux * D + (size_t)u.pn * 256) * ED; }
};
struct EpiMoe2 {
    static constexpr bool PERM = true, HAS_MID = false, HAS_PRE = true; static constexpr int NST = 9;        static constexpr int SC_W = 0x7f7f7f7f, SC_X = 0x7f7f7f7f;
    bf16_t* YS; const float* row_w; unsigned char* dump;
    __device__ __forceinline__ void pre(int pm, unsigned ldsaddr, int wid) const {
        { const unsigned la = ldsaddr + (unsigned)(wid & 3) * 256u, vo = (unsigned)lane_now() * 4u; const float* gp = row_w + pm * BM + (wid & 3) * 64;
            const unsigned long g_ = (unsigned long)gp; const float* gs = (const float*)(((unsigned long)(unsigned)__builtin_amdgcn_readfirstlane((int)(g_ >> 32)) << 32) | (unsigned long)(unsigned)__builtin_amdgcn_readfirstlane((int)g_));
            asm volatile("s_mov_b32 m0, %0\n\ts_nop 0\n\tglobal_load_lds_dword %1, %2" :: "s"(la), "v"(vo), "s"(gs) : "memory", "m0"); }
    }
    __device__ __forceinline__ void operator()(const f32x4 (&acc)[2][2][4][2], const Unit& u, int wr, int wc, int fr, int fq, unsigned ldsaddr) const {
        const int cbase = u.aux2 & 0xFFFFF, valid = u.aux2 >> 20;
        const LAS float* rwp = (const LAS float*)(unsigned long)(ldsaddr + (unsigned)(wr * 64 + fr) * 4u); float w8[2][4];
#pragma unroll
        for (int ai = 0; ai < 2; ++ai)
#pragma unroll
            for (int m = 0; m < 4; ++m) w8[ai][m] = rwp[ai * HALF + m * 16];
        const int col0 = u.pn * BM + wc * 32 + 8 * (fq & ~1) + HALF * (fq & 1);
#pragma unroll
        for (int ai = 0; ai < 2; ++ai)
#pragma unroll
            for (int m = 0; m < 4; ++m) { const int r = ai * HALF + wr * 64 + m * 16 + fr; const float w_ = w8[ai][m] * (YS_SCALE * 0.001953125f);
                const f32x4 p0 = acc[ai][0][m][0] * w_, p1 = acc[ai][0][m][1] * w_, q0 = acc[ai][1][m][0] * w_, q1 = acc[ai][1][m][1] * w_;
                const auto sl = __builtin_amdgcn_permlane16_swap((unsigned)pk4_fp8(p0[0], p0[1], p0[2], p0[3]), (unsigned)pk4_fp8(q0[0], q0[1], q0[2], q0[3]), false, false);
                const auto sh = __builtin_amdgcn_permlane16_swap((unsigned)pk4_fp8(p1[0], p1[1], p1[2], p1[3]), (unsigned)pk4_fp8(q1[0], q1[1], q1[2], q1[3]), false, false);
                unsigned char* dst = (r < valid) ? (unsigned char*)YS + (size_t)(cbase + r) * D + col0 : dump + (col0 & 1023);
                *(u32x4*)dst = (u32x4){sl[0], sh[0], sl[1], sh[1]}; }
    }
};
struct EpiYsh {
    static constexpr int SC_W = 0x7f7f7f7f, SC_X = 0x7f7f7f7f;
    static constexpr bool PERM = true, HAS_MID = false, HAS_PRE = false; static constexpr int NST = 0;
    bf16_t* O;
    __device__ __forceinline__ void operator()(const f32x4 (&acc)[2][2][4][2], const Unit& u, int wr, int wc, int fr, int fq) const {
        const int row0 = u.pm * BM + wr * 64 + fr, col0 = u.pn * BM + wc * 32 + 8 * fq;
#pragma unroll
        for (int ai = 0; ai < 2; ++ai)
#pragma unroll
            for (int m = 0; m < 4; ++m) { bf16_t* rowp = O + (size_t)(row0 + ai * HALF + m * 16) * D + col0;
#pragma unroll
                for (int bj = 0; bj < 2; ++bj) { const f32x4 v0 = acc[ai][bj][m][0], v1 = acc[ai][bj][m][1];
                    u32x4 w; w.x = cvt_pk_bf16(v0[0], v0[1]); w.y = cvt_pk_bf16(v0[2], v0[3]); w.z = cvt_pk_bf16(v1[0], v1[1]); w.w = cvt_pk_bf16(v1[2], v1[3]);
                    *(u32x4*)(rowp + bj * HALF) = w; } }
    }
};
}

__device__ __forceinline__ void f_topk(const Params& P, int* lcnt, const int tid) {
    const float* LG = (const float*)(P.ws + WS_G); const float* rb = P.in[26];
    int* tok_e = (int*)(P.ws + WS_TOKE); float* tok_w = (float*)(P.ws + WS_TOKW); int* tok_lp = (int*)(P.ws + WS_TOKLP); int* blk_cnt = (int*)(P.ws + WS_BLKCNT);
    const int TPB = NTOK / gridDim.x, lane = tid & 63, wave = tid >> 6;
    for (int i = tid; i < NE; i += NT) lcnt[i] = 0;
    __syncthreads();
    float rbv[4], nx[4];
#pragma unroll
    for (int j = 0; j < 4; ++j) { rbv[j] = rb[lane + 64 * j]; nx[j] = LG[(size_t)(blockIdx.x * TPB + wave) * NE + lane + 64 * j]; }
    for (int tt = wave; tt < TPB; tt += NT / 64) {
        const int m = blockIdx.x * TPB + tt;
        float lgv[4];
#pragma unroll
        for (int j = 0; j < 4; ++j) lgv[j] = nx[j];
        if (tt + NT / 64 < TPB) {
#pragma unroll
            for (int j = 0; j < 4; ++j) nx[j] = LG[(size_t)(m + NT / 64) * NE + lane + 64 * j]; }
        float sc[4]; unsigned key[4];
#pragma unroll
        for (int j = 0; j < 4; ++j) { const int e = lane + 64 * j; sc[j] = sigmoidf_(lgv[j]); key[j] = (__float_as_uint(sc[j] + rbv[j] + 1.0f) & 0xFFFFFF00u) | (unsigned)(255 - e); }
        float wsum = 0.f; float myw = 0.f; int mye = 0;
#define DPP_MAXU(x, ctrl) x = max(x, (unsigned)__builtin_amdgcn_update_dpp(0, (int)(x), ctrl, 0xf, 0xf, true))
        for (int r = 0; r < TOPK; ++r) {
            unsigned k = max(max(key[0], key[1]), max(key[2], key[3]));
            DPP_MAXU(k, 0xB1); DPP_MAXU(k, 0x4E); DPP_MAXU(k, 0x141); DPP_MAXU(k, 0x140);
            { auto rr = __builtin_amdgcn_permlane16_swap(k, k, false, false); k = max(rr[0], rr[1]); }
            { auto rr = __builtin_amdgcn_permlane32_swap(k, k, false, false); k = max(rr[0], rr[1]); }
            const int idx = 255 - (int)(__builtin_amdgcn_readfirstlane(k) & 255u);
            const int owner = idx & 63, jsel = idx >> 6;
            const float sj = (jsel == 0) ? sc[0] : (jsel == 1) ? sc[1] : (jsel == 2) ? sc[2] : sc[3];
            const float s = __uint_as_float(__builtin_amdgcn_readlane(__float_as_uint(sj), owner));
#pragma unroll
            for (int j = 0; j < 4; ++j) if (lane == owner && j == jsel) key[j] = 0u;
            wsum += s;
            if (lane == r) { myw = s; mye = idx; }
        }
#undef DPP_MAXU
        if (lane < TOPK) {
            const int lp = __hip_atomic_fetch_add(&lcnt[mye], 1, __ATOMIC_RELAXED, __HIP_MEMORY_SCOPE_WORKGROUP);
            tok_e[m * TOPK + lane] = mye; tok_w[m * TOPK + lane] = myw / wsum * 2.5f; tok_lp[m * TOPK + lane] = lp;
        }
    }
    __syncthreads();
    for (int i = tid; i < NE; i += NT) blk_cnt[blockIdx.x * NE + i] = lcnt[i];
    __syncthreads();
}
__device__ __forceinline__ void f_route2(const Params& P, int* sm, const int tid) {
    const int* tok_e = (const int*)(P.ws + WS_TOKE); const float* tok_w = (const float*)(P.ws + WS_TOKW); const int* tok_lp = (const int*)(P.ws + WS_TOKLP); const int* blk_cnt = (const int*)(P.ws + WS_BLKCNT);
    int* tok_dest = (int*)(P.ws + WS_TOKDEST); int* row_tok = (int*)(P.ws + WS_ROWTOK); float* row_w = (float*)(P.ws + WS_ROWW);
    int* tile_e = (int*)(P.ws + WS_TILE); int* tile_cbase = tile_e + 2048; int* tile_valid = tile_e + 4096; int* ntiles = tile_e + 6144;
    int* s_tot = sm; int* s_base = sm + 256; int* s_ps = sm + 512; int* s_cs = sm + 768; int* s_misc = sm + 1024;
    const int G = gridDim.x, TPB = NTOK / G, lane = tid & 63;
    {
        typedef int i32x4_ __attribute__((ext_vector_type(4)));
        const int wv = tid >> 6; i32x4_ tot = {0, 0, 0, 0}, base = {0, 0, 0, 0};
#pragma unroll 8
        for (int b2 = wv; b2 < G; b2 += NT / 64) { const i32x4_ v = *(const i32x4_*)(blk_cnt + b2 * NE + 4 * lane); tot += v; if (b2 < (int)blockIdx.x) base += v; }
        int* part = sm - 16384;
#pragma unroll
        for (int j = 0; j < 4; ++j) { part[wv * 512 + 4 * lane + j] = tot[j]; part[wv * 512 + 256 + 4 * lane + j] = base[j]; }
        __syncthreads();
        { const int e = tid & 255, which = tid >> 8; int s = 0;
#pragma unroll
          for (int w2 = 0; w2 < NT / 64; ++w2) s += part[w2 * 512 + which * 256 + e];
          if (which == 0) s_tot[e] = s; else s_base[e] = s; }
    }
    __syncthreads();
    if (tid < 64) {
        int t[4], sp = 0, scs = 0;
#pragma unroll
        for (int j = 0; j < 4; ++j) { t[j] = s_tot[4 * lane + j]; sp += (t[j] + 255) & ~255; scs += t[j]; }
        int ip = sp, ic = scs;
#pragma unroll
        for (int o = 1; o < 64; o <<= 1) { const int a = __shfl_up(ip, o), b = __shfl_up(ic, o); if (lane >= o) { ip += a; ic += b; } }
        int ps = ip - sp, cs = ic - scs;
#pragma unroll
        for (int j = 0; j < 4; ++j) { s_ps[4 * lane + j] = ps; s_cs[4 * lane + j] = cs; ps += (t[j] + 255) & ~255; cs += t[j]; }
        if (lane == 63) s_misc[0] = ip;
    }
    __syncthreads();
    for (int pi = tid; pi < TPB * TOPK; pi += NT) {
        const int pair = blockIdx.x * TPB * TOPK + pi; const int e = tok_e[pair]; const int li = s_base[e] + tok_lp[pair];
        const int prow = s_ps[e] + li;
        tok_dest[pair] = s_cs[e] + li; row_tok[prow] = pair / TOPK; row_w[prow] = tok_w[pair];
    }
    for (int e = blockIdx.x; e < NE; e += G) {
        const int ps = s_ps[e], tot = s_tot[e], pad = (tot + 255) & ~255;
        for (int d = ps + tot + tid; d < ps + pad; d += NT) { row_tok[d] = 0; row_w[d] = 0.f; }
        for (int ti = ps / 256 + tid; ti < (ps + pad) / 256; ti += NT) { const int off = ti * 256 - ps; tile_e[ti] = e; tile_cbase[ti] = s_cs[e] + off; tile_valid[ti] = (tot - off) < 256 ? (tot - off) : 256; }
    }
    if (blockIdx.x == 0 && tid == 0) ntiles[0] = s_misc[0] / 256;
    __syncthreads();
}
__device__ __forceinline__ void f_final(const Params& P, const Ctx& c) {
    typedef float f32x2 __attribute__((ext_vector_type(2)));
    const unsigned char* YS = (const unsigned char*)(P.ws + WS_YS); const bf16_t* YSH = (const bf16_t*)(P.ws + WS_YSH); const int* tok_dest = (const int*)(P.ws + WS_TOKDEST);
    const float* mod = (const float*)(P.ws + WS_MOD); const float* g = P.in[33]; float* X = P.out;
    int dn[TOPK];
#pragma unroll
    for (int s = 0; s < TOPK; ++s) dn[s] = tok_dest[c.gwave * TOPK + s];
    for (int m = c.gwave; m < NTOK; m += c.nwaves) {
        float tot[16];
#pragma unroll
        for (int i = 0; i < 16; ++i) tot[i] = 0.f;
        int dst[TOPK];
#pragma unroll
        for (int s = 0; s < TOPK; ++s) dst[s] = dn[s];
        if (m + c.nwaves < NTOK) {
#pragma unroll
            for (int s = 0; s < TOPK; ++s) dn[s] = tok_dest[(m + c.nwaves) * TOPK + s]; }
#pragma unroll
        for (int s = 0; s < TOPK; ++s) {
            const unsigned char* rp = YS + (size_t)dst[s] * D + 8 * c.lane;
#pragma unroll
            for (int j = 0; j < 2; ++j) { const u32x2 v = *(const u32x2*)(rp + 512 * j);
                const f32x2 a0 = __builtin_amdgcn_cvt_pk_f32_fp8((int)v[0], false), a1 = __builtin_amdgcn_cvt_pk_f32_fp8((int)v[0], true), a2 = __builtin_amdgcn_cvt_pk_f32_fp8((int)v[1], false), a3 = __builtin_amdgcn_cvt_pk_f32_fp8((int)v[1], true);
                tot[8 * j] += a0[0]; tot[8 * j + 1] += a0[1]; tot[8 * j + 2] += a1[0]; tot[8 * j + 3] += a1[1]; tot[8 * j + 4] += a2[0]; tot[8 * j + 5] += a2[1]; tot[8 * j + 6] += a3[0]; tot[8 * j + 7] += a3[1]; }
        }
        { const bf16_t* rp = YSH + (size_t)m * D + 8 * c.lane;
#pragma unroll
          for (int j = 0; j < 2; ++j) { const u32x4 v = *(const u32x4*)(rp + 512 * j);
#pragma unroll
              for (int e = 0; e < 8; ++e) tot[8 * j + e] = tot[8 * j + e] * (1.f / YS_SCALE) + pg8::bfe(v, e); } }
        const float* gt = mod + (size_t)(m / SEQ) * 6 * D + 5 * D; float* xr = X + (size_t)m * D; const bf16_t* x1r = (const bf16_t*)(P.ws + WS_X1) + (size_t)m * D; float ss = 0.f;
#pragma unroll
        for (int j = 0; j < 2; ++j)
#pragma unroll
            for (int hq = 0; hq < 2; ++hq) { const int col = 8 * c.lane + 512 * j + 4 * hq; const u32x2 xb_ = *(const u32x2*)(x1r + col); const f32x4 xv = (f32x4){pg8::bflo(xb_[0]), pg8::bfhi(xb_[0]), pg8::bflo(xb_[1]), pg8::bfhi(xb_[1])}, gv = *(const f32x4*)(gt + col);
#pragma unroll
                for (int q = 0; q < 4; ++q) { const float v = xv[q] + gv[q] * tot[8 * j + 4 * hq + q]; tot[8 * j + 4 * hq + q] = v; ss += v * v; } }
        ss = wave_sum(ss);
        const float rstd = rsqrtf(ss * (1.f / D) + 1e-6f);
#pragma unroll
        for (int j = 0; j < 2; ++j)
#pragma unroll
            for (int hq = 0; hq < 2; ++hq) { const int col = 8 * c.lane + 512 * j + 4 * hq; const f32x4 fg = *(const f32x4*)(g + col); f32x4 o;
#pragma unroll
                for (int q = 0; q < 4; ++q) o[q] = tot[8 * j + 4 * hq + q] * rstd * fg[q];
                *(f32x4*)(xr + col) = o; }
    }
}

#define XB_TMO      128
#define XB_XCNT(j)  (256  + 64 * (j))
#define XB_XSUB(j)  (1280 + 64 * (j))
#define XB_XGEN(j)  (2304 + 64 * (j))
#define XB_TOP      3328
#define XB_TOPGEN   3392
#define XCD_BAR_WORDS 3456
#define XB_SPIN_CAP (1u << 22)
__device__ __forceinline__ unsigned xb_ld(unsigned* p)              { return __hip_atomic_load(p, __ATOMIC_RELAXED, __HIP_MEMORY_SCOPE_AGENT); }
__device__ __forceinline__ unsigned xb_add(unsigned* p, unsigned v) { return __hip_atomic_fetch_add(p, v, __ATOMIC_RELAXED, __HIP_MEMORY_SCOPE_AGENT); }
__device__ __forceinline__ unsigned xb_xcc_id() { return (unsigned)__builtin_amdgcn_s_getreg((3 << 11) | 20) & 0xFu; }
#define XB_SPIN(cond, bar) do { unsigned _sp = 0; while (cond) { __builtin_amdgcn_s_sleep(1); \
    if ((++_sp & 255u) == 0u) { if (xb_ld(&(bar)[XB_TMO])) break; if (_sp > XB_SPIN_CAP) { atomicAdd(&(bar)[XB_TMO], 1u); break; } } } } while (0)
struct XcdBarrier { unsigned* bar; unsigned x; volatile LAS unsigned* st; };
__device__ __forceinline__ XcdBarrier xcd_barrier_post(unsigned* bar, volatile LAS unsigned* st, int tid) {
    XcdBarrier b; b.bar = bar; b.x = xb_xcc_id(); b.st = st;
    if (tid == 0) (void)xb_add(&bar[XB_XCNT(b.x)], 1u);
    return b;
}
__device__ __forceinline__ void xcd_barrier_complete(unsigned* bar, unsigned x, unsigned& nloc, unsigned& nx) {
    const unsigned G = gridDim.x * gridDim.y * gridDim.z;
    unsigned sum, cnt, mine, sp = 0u;
    for (;;) {
        sum = 0u; cnt = 0u; mine = 0u;
#pragma unroll
        for (unsigned j = 0; j < 16; ++j) { const unsigned c = xb_ld(&bar[XB_XCNT(j)]); sum += c; cnt += (c > 0u) ? 1u : 0u; mine = (j == x) ? c : mine; }
        if (sum == G) break;
        __builtin_amdgcn_s_sleep(1);
        if ((++sp & 255u) == 0u) { if (xb_ld(&bar[XB_TMO])) break; if (sp > XB_SPIN_CAP) { atomicAdd(&bar[XB_TMO], 1u); break; } }
    }
    nloc = mine > 0u ? mine : 1u; nx = cnt > 0u ? cnt : 1u;
}
__device__ __forceinline__ void xcd_barrier(const XcdBarrier& b, int tid) {
    asm volatile("s_waitcnt vmcnt(0)" ::: "memory");
    __syncthreads();
    if (tid == 0) {
        unsigned* bar = b.bar;
        __builtin_amdgcn_s_waitcnt(0);
        unsigned nloc = b.st[0], nx = b.st[1];
        if (nloc == 0u) { xcd_barrier_complete(bar, b.x, nloc, nx); b.st[0] = nloc; b.st[1] = nx; }
        const unsigned old = xb_add(&bar[XB_XSUB(b.x)], 1u);
        const unsigned gen = old / nloc;
        if (old + 1u == (gen + 1u) * nloc) {
            __builtin_amdgcn_fence(__ATOMIC_RELEASE, "agent");
            asm volatile("s_waitcnt vmcnt(0)" ::: "memory");
            const unsigned og = xb_add(&bar[XB_TOP], 1u);
            const unsigned tg = og / nx;
            if (og + 1u == (tg + 1u) * nx) xb_add(&bar[XB_TOPGEN], 1u);
            else XB_SPIN(xb_ld(&bar[XB_TOPGEN]) == tg, bar);
            __builtin_amdgcn_fence(__ATOMIC_ACQUIRE, "agent");
            xb_add(&bar[XB_XGEN(b.x)], 1u);
            asm volatile("s_waitcnt vmcnt(0)" ::: "memory");
        } else {
            XB_SPIN(xb_ld(&bar[XB_XGEN(b.x)]) == gen, bar);
            __builtin_amdgcn_fence(__ATOMIC_ACQUIRE, "agent");
            asm volatile("s_waitcnt vmcnt(0)" ::: "memory");
        }
    }
    __syncthreads();
}

#define DPP_ADD(x, ctrl) x += __uint_as_float(__builtin_amdgcn_update_dpp(0, __float_as_uint(x), ctrl, 0xf, 0xf, true))
__device__ __forceinline__ float red32(float x) {
    DPP_ADD(x, 0xB1); DPP_ADD(x, 0x4E); DPP_ADD(x, 0x141); DPP_ADD(x, 0x140);
    auto rr = __builtin_amdgcn_permlane16_swap(__float_as_uint(x), __float_as_uint(x), false, false);
    return __uint_as_float(rr[0]) + __uint_as_float(rr[1]);
}
__device__ __forceinline__ float fma_s(float a, float b, float c) { float r; asm("v_fma_f32 %0, %1, %2, %3" : "=v"(r) : "v"(a), "v"(b), "v"(c)); return r; }
__device__ __forceinline__ float mul_s(float a, float b) { float r; asm("v_mul_f32_e32 %0, %1, %2" : "=v"(r) : "v"(a), "v"(b)); return r; }
__device__ __forceinline__ float add_s(float a, float b) { float r; asm("v_add_f32_e32 %0, %1, %2" : "=v"(r) : "v"(a), "v"(b)); return r; }
__device__ __forceinline__ void f_scan(const Params& P, LAS unsigned char* lds, int tid) {
    constexpr int NCHK = SEQ / 16, SLOT = 16384, RD = 8, AHEAD = 7, PPL = 4;
    static_assert(RD * SLOT <= LDS_BYTES, "scan ring");
    const int lane = tid & 63, w = __builtin_amdgcn_readfirstlane(tid >> 6), c16 = lane & 15, g = lane >> 4;
    const int bh = blockIdx.x;
    if (bh >= NB * 8) return;
    const int b = bh >> 3, h = bh & 7;
    const unsigned char* ops = ops_ptr(P, bh);
    const bf16_t* SVb = (const bf16_t*)(P.ws + WS_SCANV) + (size_t)b * SEQ * CW + h * 64;
    if (w >= 4) {
        const int hw = w - 4;
        const unsigned lo_op = (unsigned)lane * 16u, lo_v = (unsigned)((lane >> 3) * CW + (lane & 7) * 8) * 2u;
#define SC_ISSUE(ch_) do { unsigned cc_ = (unsigned)(ch_); asm volatile("" : "+s"(cc_)); const unsigned so_ = (cc_ & (RD - 1)) * SLOT; \
            _Pragma("unroll") for (int n_ = 0; n_ < PPL; ++n_) { const int p_ = hw * PPL + n_; \
                if (p_ < 13) __builtin_amdgcn_global_load_lds((const unsigned*)(ops + (size_t)cc_ * OPB + p_ * 1024 + lo_op), (LAS unsigned*)(lds + so_ + p_ * 1024), 16, 0, 0); \
                else if (p_ < 15) __builtin_amdgcn_global_load_lds((const unsigned*)((const char*)(SVb + (size_t)(cc_ * 16 + (p_ - 13) * 8) * CW) + lo_v), (LAS unsigned*)(lds + so_ + 13312 + (p_ - 13) * 1024), 16, 0, 0); \
                else __builtin_amdgcn_global_load_lds((const unsigned*)(ops + (size_t)cc_ * OPB + lo_op), (LAS unsigned*)(lds + so_ + 15360), 16, 0, 0); } } while (0)
        for (int c0 = 0; c0 < AHEAD; ++c0) SC_ISSUE(c0);
        for (int ch = 0; ch < NCHK; ++ch) {
            if (ch + AHEAD - 1 < NCHK) asm volatile("s_waitcnt vmcnt(20)" ::: "memory");
            else asm volatile("s_waitcnt vmcnt(0)" ::: "memory");
            __builtin_amdgcn_s_barrier();
            if (ch + AHEAD < NCHK) SC_ISSUE(ch + AHEAD);
        }
#undef SC_ISSUE
    } else {
        const int rho0 = 16 * w;
        bf16_t* Y = (bf16_t*)(P.ws + WS_Y) + (size_t)b * SEQ * CW + h * 64 + rho0 + c16 + (size_t)(4 * g) * CW;
        f32x4 D0 = (f32x4){0.f, 0.f, 0.f, 0.f}, D1 = D0, D2 = D0, D3 = D0;
        u32x4 gf[8], rf[2]; u32x2 hf[4], mf; bf16_t vv[4];
#define SC_RD(ch_, GF, RF, HF, MF, VV) do { const LAS unsigned char* sl_ = lds + ((ch_) & (RD - 1)) * SLOT; \
            _Pragma("unroll") for (int i_ = 0; i_ < 8; ++i_) GF[i_] = *(const LAS u32x4*)(sl_ + i_ * 1024 + lane * 16); \
            RF[0] = *(const LAS u32x4*)(sl_ + 8192 + lane * 16); RF[1] = *(const LAS u32x4*)(sl_ + 9216 + lane * 16); \
            _Pragma("unroll") for (int i_ = 0; i_ < 4; ++i_) HF[i_] = *(const LAS u32x2*)(sl_ + 10240 + i_ * 512 + lane * 8); \
            MF = *(const LAS u32x2*)(sl_ + 12288 + lane * 8); \
            _Pragma("unroll") for (int e_ = 0; e_ < 4; ++e_) VV[e_] = *(const LAS bf16_t*)(sl_ + 13312 + (4 * g + e_) * 128 + (rho0 + c16) * 2); } while (0)
        for (int ch = 0; ch < NCHK; ++ch) {
            __builtin_amdgcn_s_barrier();
            asm volatile("" ::: "memory");
            if (ch == 0) SC_RD(0, gf, rf, hf, mf, vv);
            u32x4 ngf[8], nrf[2]; u32x2 nhf[4], nmf; bf16_t nvv[4];
            { const int chn = (ch + 1 < NCHK) ? ch + 1 : ch; SC_RD(chn, ngf, nrf, nhf, nmf, nvv); }
            __builtin_amdgcn_sched_barrier(0);
            u32x4 bs0, bs1, bv;
            bs0.x = pg8::cvt_pk_bf16(D0[0], D0[1]); bs0.y = pg8::cvt_pk_bf16(D0[2], D0[3]); bs0.z = pg8::cvt_pk_bf16(D1[0], D1[1]); bs0.w = pg8::cvt_pk_bf16(D1[2], D1[3]);
            bs1.x = pg8::cvt_pk_bf16(D2[0], D2[1]); bs1.y = pg8::cvt_pk_bf16(D2[2], D2[3]); bs1.z = pg8::cvt_pk_bf16(D3[0], D3[1]); bs1.w = pg8::cvt_pk_bf16(D3[2], D3[3]);
            bv.x = (unsigned)vv[0] | ((unsigned)vv[1] << 16); bv.y = (unsigned)vv[2] | ((unsigned)vv[3] << 16); bv.z = 0u; bv.w = 0u;
            const bf16x8 B0 = __builtin_bit_cast(bf16x8, bs0), B1 = __builtin_bit_cast(bf16x8, bs1), BV = __builtin_bit_cast(bf16x8, bv);
            const f32x4 z4 = (f32x4){0.f, 0.f, 0.f, 0.f};
#define SC_TILE(mt_) ({ f32x4 n_ = __builtin_amdgcn_mfma_f32_16x16x32_bf16(__builtin_bit_cast(bf16x8, gf[2 * (mt_)]), B0, z4, 0, 0, 0); \
                n_ = __builtin_amdgcn_mfma_f32_16x16x32_bf16(__builtin_bit_cast(bf16x8, gf[2 * (mt_) + 1]), B1, n_, 0, 0, 0); \
                const u32x4 h_ = (u32x4){hf[mt_][0], hf[mt_][1], 0u, 0u}; \
                __builtin_amdgcn_mfma_f32_16x16x32_bf16(__builtin_bit_cast(bf16x8, h_), BV, n_, 0, 0, 0); })
            const f32x4 n0 = SC_TILE(0), n1 = SC_TILE(1), n2 = SC_TILE(2), n3 = SC_TILE(3);
            f32x4 yt = __builtin_amdgcn_mfma_f32_16x16x32_bf16(__builtin_bit_cast(bf16x8, rf[0]), B0, z4, 0, 0, 0);
            yt = __builtin_amdgcn_mfma_f32_16x16x32_bf16(__builtin_bit_cast(bf16x8, rf[1]), B1, yt, 0, 0, 0);
            { const u32x4 m_ = (u32x4){mf[0], mf[1], 0u, 0u}; yt = __builtin_amdgcn_mfma_f32_16x16x32_bf16(__builtin_bit_cast(bf16x8, m_), BV, yt, 0, 0, 0); }
            D0 = n0; D1 = n1; D2 = n2; D3 = n3;
#pragma unroll
            for (int r_ = 0; r_ < 4; ++r_) Y[(size_t)(ch * 16 + r_) * CW] = f2bf(yt[r_]);
#pragma unroll
            for (int i_ = 0; i_ < 8; ++i_) gf[i_] = ngf[i_];
            rf[0] = nrf[0]; rf[1] = nrf[1];
#pragma unroll
            for (int i_ = 0; i_ < 4; ++i_) { hf[i_] = nhf[i_]; vv[i_] = nvv[i_]; }
            mf = nmf;
            asm volatile("s_waitcnt lgkmcnt(0)" ::: "memory");
#undef SC_TILE
        }
#undef SC_RD
    }
}

__device__ __forceinline__ void f_mod(const Params& P, LAS unsigned char* lds, int tid) {
    const float* cc = P.in[1]; const float* w = P.in[2]; const float* bias = P.in[3];
    float* mod = (float*)(P.ws + WS_MOD);
    LAS float* sc = (LAS float*)lds;
    LAS float* red = (LAS float*)(lds + 32768);
    const int lane = tid & 63, wv = __builtin_amdgcn_readfirstlane(tid >> 6);
    for (int item = blockIdx.x; item < 96; item += gridDim.x) {
        for (int i = tid; i < NB * D; i += NT) sc[i] = siluf_(cc[i]);
        __syncthreads();
        const int col = item * 64 + lane;
        float acc[NB];
#pragma unroll
        for (int i = 0; i < NB; ++i) acc[i] = 0.f;
#pragma unroll 16
        for (int k = wv * 128; k < wv * 128 + 128; ++k) {
            const float x = w[(size_t)k * 6 * D + col];
#pragma unroll
            for (int i = 0; i < NB; ++i) acc[i] += sc[i * D + k] * x;
        }
#pragma unroll
        for (int i = 0; i < NB; ++i) red[(wv * NB + i) * 64 + lane] = acc[i];
        __syncthreads();
        { const int i = tid >> 6; float s = 0.f;
#pragma unroll
          for (int w2 = 0; w2 < 8; ++w2) s += red[(w2 * NB + i) * 64 + lane];
          mod[i * 6 * D + col] = s + bias[col]; }
        __syncthreads();
    }
}

#define DPP_ADDF(x, ctrl) x += __uint_as_float(__builtin_amdgcn_update_dpp(0, __float_as_uint(x), ctrl, 0xf, 0xf, true))
__device__ __forceinline__ float red16(float x) { DPP_ADDF(x, 0xB1); DPP_ADDF(x, 0x4E); DPP_ADDF(x, 0x141); DPP_ADDF(x, 0x140); return x; }
__device__ __forceinline__ float red64(float x) {
    x = red16(x);
    { auto rr = __builtin_amdgcn_permlane16_swap(__float_as_uint(x), __float_as_uint(x), false, false); x = __uint_as_float(rr[0]) + __uint_as_float(rr[1]); }
    { auto rr = __builtin_amdgcn_permlane32_swap(__float_as_uint(x), __float_as_uint(x), false, false); x = __uint_as_float(rr[0]) + __uint_as_float(rr[1]); }
    return x;
}
__device__ __forceinline__ float fast_tanh(float x) { const float t = __expf(2.f * x); return 1.f - 2.f * __builtin_amdgcn_rcpf(t + 1.f); }
__device__ __forceinline__ float fast_sig(float x) { return __builtin_amdgcn_rcpf(1.f + __expf(-x)); }
__device__ __forceinline__ float fast_gelu(float x) { return 0.5f * x * (1.f + fast_tanh(0.7978845608028654f * (x + 0.044715f * x * x * x))); }

__device__ __forceinline__ void f_prep_gmlp(const Params& P, LAS unsigned char* lds, int tid) {
    typedef float f32x2 __attribute__((ext_vector_type(2)));
    const bf16_t* Pp = (const bf16_t*)(P.ws + WS_P);
    const float *mu = P.in[6], *w0 = P.in[7], *a0 = P.in[9], *k_k = P.in[12], *k_a = P.in[13], *r_k = P.in[14];
    const float *lng = P.in[17], *lnb = P.in[18], *wsp = P.in[19], *bsp = P.in[20];
    const bf16_t* w2t = (const bf16_t*)(P.ws + WS_LORA); const bf16_t* a2t = w2t + 512 * 64; const bf16_t* g2t = a2t + 512 * 64;
    bf16_t* SV = (bf16_t*)(P.ws + WS_SCANV);
    float* Gb = (float*)(P.ws + WS_G); float* bonus = (float*)(P.ws + WS_BONUS);
    bf16_t* O = (bf16_t*)(P.ws + WS_O);
    const int lane = tid & 63, w = __builtin_amdgcn_readfirstlane(tid >> 6), c16 = lane & 15, q4 = lane >> 4;
    constexpr int AST = 528;
    constexpr int VST = 272, VWAVE = 64 * VST;
    if (blockIdx.x < NTOK / 128) {
        const int unit = blockIdx.x; const int m0 = unit * 128;
        constexpr int ATILE = 16 * AST, CONST_OFF = 2 * ATILE, SCR0 = CONST_OFF + 16384, SCRW = 15104;
        constexpr int XS = 144;
        constexpr int O_XA = 0, O_XR = 2304, O_XB = 4608, O_XK = 6912, O_BN = 9216, O_BP = 10304, O_BQ = 11392, O_AT = 12480, O_ECL = 14784;
        static_assert(O_AT + 64 * 32 <= O_ECL && O_ECL + 256 <= SCRW && SCR0 + 8 * SCRW <= LDS_BYTES, "prep LDS map");
        {
            LAS float* cf = (LAS float*)(lds + CONST_OFF);
            const int cidx = tid;
            cf[cidx] = mu[cidx]; cf[512 + cidx] = mu[512 + cidx]; cf[1024 + cidx] = mu[1024 + cidx]; cf[1536 + cidx] = w0[cidx]; cf[2048 + cidx] = a0[cidx]; cf[2560 + cidx] = k_k[cidx]; cf[3072 + cidx] = k_a[cidx]; cf[3584 + cidx] = r_k[cidx];
        }
        const int a_row = tid >> 5, a_l32 = tid & 31, a_col8 = 8 * a_l32;
        float mu8[8];
#pragma unroll
        for (int e = 0; e < 8; ++e) mu8[e] = mu[1536 + a_col8 + e];
#define PREP_ATILE(mt_, buf_) do { const int m_ = m0 + 16 * (mt_) + a_row; \
            const u32x4 pc_ = *(const u32x4*)(Pp + (size_t)m_ * INC + 1536 + a_col8); u32x4 pp_ = (u32x4){0u, 0u, 0u, 0u}; \
            if (m_ % SEQ) pp_ = *(const u32x4*)(Pp + (size_t)(m_ - 1) * INC + 1536 + a_col8); \
            float v_[8]; \
            _Pragma("unroll") for (int e = 0; e < 8; ++e) { const float x_ = pg8::bfe(pc_, e), xp_ = pg8::bfe(pp_, e); const float xs_ = x_ + (xp_ - x_) * mu8[e]; \
                v_[e] = (a_l32 < 8) ? fast_tanh(xs_) : ((a_l32 < 16) ? xs_ : fast_sig(xs_)); } \
            u32x4 o_; o_.x = pg8::cvt_pk_bf16(v_[0], v_[1]); o_.y = pg8::cvt_pk_bf16(v_[2], v_[3]); o_.z = pg8::cvt_pk_bf16(v_[4], v_[5]); o_.w = pg8::cvt_pk_bf16(v_[6], v_[7]); \
            *(LAS u32x4*)(lds + (buf_) * ATILE + a_row * AST + a_col8 * 2) = o_; } while (0)
        PREP_ATILE(0, 0);
        __syncthreads();
        {
            const int colb = 64 * w + 4 * c16;
            const LAS f32x4* cst = (const LAS f32x4*)(lds + CONST_OFF) + (colb >> 2);
            const char* P8 = (const char*)Pp;
            LAS unsigned char* scr = lds + SCR0 + w * SCRW;
            const int bh = (m0 / SEQ) * 8 + w;
            unsigned char* opsb = ops_ptr(P, bh) + (size_t)((m0 % SEQ) / 16) * OPB;
#define PREP_LOAD(rr_, CR, CK, CV, QR, QK, QV) do { const int m_ = m0 + 16 * mt + 4 * q4 + (rr_); const unsigned pb_ = (unsigned)(m_ * INC + colb) * 2u; \
                CR = *(const uint2*)(P8 + pb_); CK = *(const uint2*)(P8 + pb_ + 1024u); CV = *(const uint2*)(P8 + pb_ + 2048u); QR = make_uint2(0u, 0u); QK = QR; QV = QR; \
                if (m_ % SEQ) { const unsigned qb_ = pb_ - (unsigned)(INC * 2); QR = *(const uint2*)(P8 + qb_); QK = *(const uint2*)(P8 + qb_ + 1024u); QV = *(const uint2*)(P8 + qb_ + 2048u); } } while (0)
            for (int mt = 0; mt < 8; ++mt) {
                if (mt + 1 < 8) PREP_ATILE(mt + 1, (mt + 1) & 1);
                uint2 cr, ck, cv, qr, qk, qv, ncr, nck, ncv, nqr, nqk, nqv;
                PREP_LOAD(0, cr, ck, cv, qr, qk, qv);
                f32x4 aw[4], aa[4], ag[4];
#pragma unroll
                for (int j = 0; j < 4; ++j) { aw[j] = (f32x4){0.f, 0.f, 0.f, 0.f}; aa[j] = aw[j]; ag[j] = aw[j]; }
                const LAS unsigned char* arow = lds + (mt & 1) * ATILE + c16 * AST + 16 * q4;
#pragma unroll
                for (int ks = 0; ks < 2; ++ks) {
                    const bf16x8 fw = *(const LAS bf16x8*)(arow + ks * 64), fa = *(const LAS bf16x8*)(arow + 128 + ks * 64);
#pragma unroll
                    for (int j = 0; j < 4; ++j) {
                        const bf16x8 bw = *(const bf16x8*)(w2t + (size_t)(colb + j) * 64 + ks * 32 + 8 * q4), ba = *(const bf16x8*)(a2t + (size_t)(colb + j) * 64 + ks * 32 + 8 * q4);
                        aw[j] = __builtin_amdgcn_mfma_f32_16x16x32_bf16(fw, bw, aw[j], 0, 0, 0);
                        aa[j] = __builtin_amdgcn_mfma_f32_16x16x32_bf16(fa, ba, aa[j], 0, 0, 0);
                    }
                }
#pragma unroll
                for (int ks = 0; ks < 4; ++ks) {
                    const bf16x8 fg = *(const LAS bf16x8*)(arow + 256 + ks * 64);
#pragma unroll
                    for (int j = 0; j < 4; ++j) { const bf16x8 bg = *(const bf16x8*)(g2t + (size_t)(colb + j) * 128 + ks * 32 + 8 * q4); ag[j] = __builtin_amdgcn_mfma_f32_16x16x32_bf16(fg, bg, ag[j], 0, 0, 0); }
                }
                float ta[4][4], tb[4][4], tk[4][4], tr[4][4], tl[4][4];
#pragma unroll
                for (int rr = 0; rr < 4; ++rr) {
                    const int m = m0 + 16 * mt + 4 * q4 + rr;
                    if (rr < 3) PREP_LOAD(rr + 1, ncr, nck, ncv, nqr, nqk, nqv);
                    const f32x4 mur = cst[0], muk = cst[128], muv = cst[256], w0v = cst[384], a0v = cst[512], kkv = cst[640], kav = cst[768], rkv = cst[896];
                    float v4[4], an[4], bn4[4];
                    float ss = 0.f, bsum = 0.f;
#pragma unroll
                    for (int j = 0; j < 4; ++j) {
                        const unsigned wr_ = (j < 2) ? cr.x : cr.y, wk_ = (j < 2) ? ck.x : ck.y, wv_ = (j < 2) ? cv.x : cv.y, pr_ = (j < 2) ? qr.x : qr.y, pk_ = (j < 2) ? qk.x : qk.y, pv_ = (j < 2) ? qv.x : qv.y;
                        const float xr = (j & 1) ? pg8::bfhi(wr_) : pg8::bflo(wr_), xk = (j & 1) ? pg8::bfhi(wk_) : pg8::bflo(wk_), xv = (j & 1) ? pg8::bfhi(wv_) : pg8::bflo(wv_);
                        const float yr = (j & 1) ? pg8::bfhi(pr_) : pg8::bflo(pr_), yk = (j & 1) ? pg8::bfhi(pk_) : pg8::bflo(pk_), yv = (j & 1) ? pg8::bfhi(pv_) : pg8::bflo(pv_);
                        const float r1 = xr + (yr - xr) * mur[j], k1 = xk + (yk - xk) * muk[j]; v4[j] = xv + (yv - xv) * muv[j];
                        const float z = -(w0v[j] + aw[j][rr]);
                        const float sp = fmaxf(z, 0.f) + __logf(1.f + __expf(-fabsf(z)));
                        tl[rr][j] = -__expf(-sp - 0.5f);
                        const float a = fast_sig(a0v[j] + aa[j][rr]);
                        const float kk = k1 * kkv[j];
                        ss += kk * kk;
                        tk[rr][j] = k1 * (1.f + (a - 1.f) * kav[j]);
                        tr[rr][j] = r1;
                        bsum += r1 * tk[rr][j] * rkv[j];
                        an[j] = kk; bn4[j] = a;
                    }
                    ss = red16(ss); bsum = red16(bsum);
                    const float rn = rsqrtf(fmaxf(ss, 1e-24f));
                    const unsigned ob = (unsigned)(m * CW + colb) * 4u;
                    f32x4 oV, oG;
#pragma unroll
                    for (int j = 0; j < 4; ++j) { const float kkn = an[j] * rn; ta[rr][j] = -kkn; tb[rr][j] = kkn * bn4[j]; oV[j] = v4[j]; oG[j] = ag[j][rr]; }
                    *(u32x2*)((char*)SV + (ob >> 1)) = (u32x2){pg8::cvt_pk_bf16(oV[0], oV[1]), pg8::cvt_pk_bf16(oV[2], oV[3])}; *(u32x2*)((char*)Gb + (ob >> 1)) = (u32x2){pg8::cvt_pk_bf16(oG[0], oG[1]), pg8::cvt_pk_bf16(oG[2], oG[3])};
                    if (c16 == 0) bonus[m * 8 + w] = bsum;
                    cr = ncr; ck = nck; cv = ncv; qr = nqr; qk = nqk; qv = nqv;
                }
                float cinc[4][4], cL[4];
#pragma unroll
                for (int j = 0; j < 4; ++j) {
                    float run = 0.f;
#pragma unroll
                    for (int rr = 0; rr < 4; ++rr) { run += tl[rr][j]; cinc[rr][j] = run; }
                    const float t1 = __shfl(run, (lane - 16) & 63), t2 = __shfl(run, (lane - 32) & 63), t3 = __shfl(run, (lane - 48) & 63);
                    const float off = (q4 >= 1 ? t1 : 0.f) + (q4 >= 2 ? t2 : 0.f) + (q4 >= 3 ? t3 : 0.f);
#pragma unroll
                    for (int rr = 0; rr < 4; ++rr) cinc[rr][j] += off;
                    cL[j] = __shfl(cinc[3][j], 48 + c16);
                }
#pragma unroll
                for (int rr = 0; rr < 4; ++rr) {
                    float xa[4], xr_[4], xb[4], xk[4];
#pragma unroll
                    for (int j = 0; j < 4; ++j) { const float ec = __expf(cinc[rr][j]), ecx = __expf(cinc[rr][j] - tl[rr][j]), en = __expf(-cinc[rr][j]);
                        xa[j] = ta[rr][j] * ecx; xr_[j] = tr[rr][j] * ec; xb[j] = tb[rr][j] * en; xk[j] = tk[rr][j] * en; }
                    LAS unsigned char* xp = scr + (4 * q4 + rr) * XS + c16 * 8;
                    *(LAS u32x2*)(xp + O_XA) = (u32x2){pg8::cvt_pk_bf16(xa[0], xa[1]), pg8::cvt_pk_bf16(xa[2], xa[3])};
                    *(LAS u32x2*)(xp + O_XR) = (u32x2){pg8::cvt_pk_bf16(xr_[0], xr_[1]), pg8::cvt_pk_bf16(xr_[2], xr_[3])};
                    *(LAS u32x2*)(xp + O_XB) = (u32x2){pg8::cvt_pk_bf16(xb[0], xb[1]), pg8::cvt_pk_bf16(xb[2], xb[3])};
                    *(LAS u32x2*)(xp + O_XK) = (u32x2){pg8::cvt_pk_bf16(xk[0], xk[1]), pg8::cvt_pk_bf16(xk[2], xk[3])};
                }
                if (q4 == 0) *(LAS f32x4*)(scr + O_ECL + c16 * 16) = (f32x4){__expf(cL[0]), __expf(cL[1]), __expf(cL[2]), __expf(cL[3])};
                asm volatile("s_waitcnt lgkmcnt(0)" ::: "memory");
#define SM_WR(off_, v_) do { _Pragma("unroll") for (int r_ = 0; r_ < 4; ++r_) *(LAS float*)(scr + (off_) + ((4 * q4 + r_) * 17 + c16) * 4) = (v_)[r_]; } while (0)
#define SM_A(off_, kk_) (*(const LAS float*)(scr + (off_) + (c16 * 17 + 4 * (kk_) + q4) * 4))
#define SM_B(off_, kk_) (*(const LAS float*)(scr + (off_) + ((4 * (kk_) + q4) * 17 + c16) * 4))
#define XV(off_, tok_, col_) bf2f(*(const LAS bf16_t*)(scr + (off_) + (tok_) * XS + (col_) * 2))
                f32x4 mN = (f32x4){0.f, 0.f, 0.f, 0.f}, mK = mN, mQb = mN, mQk = mN;
                {
                    const LAS unsigned char* rowp = scr + c16 * XS + 16 * q4;
#pragma unroll
                    for (int ks = 0; ks < 2; ++ks) {
                        const bf16x8 fa = *(const LAS bf16x8*)(rowp + O_XA + 64 * ks), fr = *(const LAS bf16x8*)(rowp + O_XR + 64 * ks), fb = *(const LAS bf16x8*)(rowp + O_XB + 64 * ks), fk = *(const LAS bf16x8*)(rowp + O_XK + 64 * ks);
                        mN = __builtin_amdgcn_mfma_f32_16x16x32_bf16(fb, fa, mN, 0, 0, 0); mK = __builtin_amdgcn_mfma_f32_16x16x32_bf16(fk, fa, mK, 0, 0, 0);
                        mQb = __builtin_amdgcn_mfma_f32_16x16x32_bf16(fb, fr, mQb, 0, 0, 0); mQk = __builtin_amdgcn_mfma_f32_16x16x32_bf16(fk, fr, mQk, 0, 0, 0);
                    }
#pragma unroll
                    for (int r_ = 0; r_ < 4; ++r_) { const int s_ = 4 * q4 + r_; if (!(s_ < c16)) { mN[r_] = 0.f; mK[r_] = 0.f; } if (!(s_ <= c16)) { mQb[r_] = 0.f; mQk[r_] = 0.f; } }
                }
#define SM_MUL(dst_, offA_, idA_, offB_, idB_) do { dst_ = (f32x4){0.f, 0.f, 0.f, 0.f}; _Pragma("unroll") for (int kk_ = 0; kk_ < 4; ++kk_) { \
                        float a_ = SM_A(offA_, kk_), b_ = SM_B(offB_, kk_); if ((idA_) && c16 == 4 * kk_ + q4) a_ += 1.f; if ((idB_) && c16 == 4 * kk_ + q4) b_ += 1.f; \
                        dst_ = __builtin_amdgcn_mfma_f32_16x16x4f32(a_, b_, dst_, 0, 0, 0); } } while (0)
#define LFENCE() asm volatile("s_waitcnt lgkmcnt(0)" ::: "memory")
                f32x4 t0, t1v, t2v;
                SM_WR(O_BN, mN); LFENCE();
                SM_MUL(t0, O_BN, false, O_BN, false);
                SM_WR(O_BP, t0); LFENCE();
                SM_MUL(t1v, O_BN, true, O_BP, true);
                SM_MUL(t2v, O_BP, false, O_BP, false);
                LFENCE(); SM_WR(O_BN, t2v); SM_WR(O_BQ, t1v); LFENCE();
                SM_MUL(t0, O_BN, false, O_BN, false);
                SM_MUL(t1v, O_BQ, false, O_BN, true);
                LFENCE(); SM_WR(O_BP, t0); SM_WR(O_BQ, t1v); LFENCE();
                SM_MUL(t2v, O_BQ, false, O_BP, true);
                LFENCE(); SM_WR(O_BN, t2v); SM_WR(O_BP, mK); LFENCE();
                {
                    f32x4 at[4];
#pragma unroll
                    for (int mt2 = 0; mt2 < 4; ++mt2) { at[mt2] = (f32x4){0.f, 0.f, 0.f, 0.f};
#pragma unroll
                        for (int kk = 0; kk < 4; ++kk) at[mt2] = __builtin_amdgcn_mfma_f32_16x16x4f32(XV(O_XA, 4 * kk + q4, 16 * mt2 + c16), SM_B(O_BN, kk), at[mt2], 0, 0, 0); }
                    SM_MUL(t0, O_BP, false, O_BN, false);
#pragma unroll
                    for (int mt2 = 0; mt2 < 4; ++mt2)
#pragma unroll
                        for (int r_ = 0; r_ < 4; ++r_) *(LAS bf16_t*)(scr + O_AT + (16 * mt2 + 4 * q4 + r_) * 32 + c16 * 2) = f2bf(at[mt2][r_]);
                    LFENCE(); SM_WR(O_BQ, t0); SM_WR(O_BP, mQb); LFENCE();
                }
#define AT_A(j_, kk_) bf2f(*(const LAS bf16_t*)(scr + O_AT + (j_) * 32 + (4 * (kk_) + q4) * 2))
                {
                    f32x4 ry[4];
#pragma unroll
                    for (int mt2 = 0; mt2 < 4; ++mt2) { ry[mt2] = (f32x4){0.f, 0.f, 0.f, 0.f};
#pragma unroll
                        for (int kk = 0; kk < 4; ++kk) ry[mt2] = __builtin_amdgcn_mfma_f32_16x16x4f32(AT_A(16 * mt2 + c16, kk), SM_B(O_BP, kk), ry[mt2], 0, 0, 0);
#pragma unroll
                        for (int r_ = 0; r_ < 4; ++r_) ry[mt2][r_] += XV(O_XR, c16, 16 * mt2 + 4 * q4 + r_); }
                    SM_MUL(t0, O_BQ, false, O_BP, false);
#pragma unroll
                    for (int r_ = 0; r_ < 4; ++r_) t0[r_] += mQk[r_];
#pragma unroll
                    for (int s2 = 0; s2 < 2; ++s2) { u32x4 o; o.x = pg8::cvt_pk_bf16(ry[2 * s2][0], ry[2 * s2][1]); o.y = pg8::cvt_pk_bf16(ry[2 * s2][2], ry[2 * s2][3]); o.z = pg8::cvt_pk_bf16(ry[2 * s2 + 1][0], ry[2 * s2 + 1][1]); o.w = pg8::cvt_pk_bf16(ry[2 * s2 + 1][2], ry[2 * s2 + 1][3]);
                        *(u32x4*)(opsb + (size_t)mt * OPB + 8192 + s2 * 1024 + lane * 16) = o; }
                    *(uint2*)(opsb + (size_t)mt * OPB + 12288 + lane * 8) = make_uint2(pg8::cvt_pk_bf16(t0[0], t0[1]), pg8::cvt_pk_bf16(t0[2], t0[3]));
                }
                {
                    u32x2 own[4];
#pragma unroll
                    for (int rr = 0; rr < 4; ++rr) own[rr] = *(const LAS u32x2*)(scr + O_XB + (4 * q4 + rr) * XS + c16 * 8);
                    LFENCE();
#pragma unroll
                    for (int j = 0; j < 4; ++j) { const unsigned w0_ = own[0][j >> 1], w1_ = own[1][j >> 1], w2_ = own[2][j >> 1], w3_ = own[3][j >> 1];
                        const unsigned e0 = (j & 1) ? (w0_ >> 16) : (w0_ & 0xffffu), e1 = (j & 1) ? (w1_ >> 16) : (w1_ & 0xffffu), e2 = (j & 1) ? (w2_ >> 16) : (w2_ & 0xffffu), e3 = (j & 1) ? (w3_ >> 16) : (w3_ & 0xffffu);
                        *(LAS u32x2*)(scr + O_XB + (4 * c16 + j) * 32 + q4 * 8) = (u32x2){e0 | (e1 << 16), e2 | (e3 << 16)}; }
                    LFENCE();
                    const bf16x8 zf = (bf16x8){0, 0, 0, 0, 0, 0, 0, 0};
                    bf16x8 fat[4], fmt = zf;
#pragma unroll
                    for (int mt2 = 0; mt2 < 4; ++mt2) fat[mt2] = (q4 < 2) ? *(const LAS bf16x8*)(scr + O_AT + (16 * mt2 + c16) * 32 + 16 * q4) : zf;
                    if (q4 < 2) { float mv[8];
#pragma unroll
                        for (int e = 0; e < 8; ++e) mv[e] = *(const LAS float*)(scr + O_BQ + (c16 * 17 + 8 * q4 + e) * 4);
                        u32x4 mu_; mu_.x = pg8::cvt_pk_bf16(mv[0], mv[1]); mu_.y = pg8::cvt_pk_bf16(mv[2], mv[3]); mu_.z = pg8::cvt_pk_bf16(mv[4], mv[5]); mu_.w = pg8::cvt_pk_bf16(mv[6], mv[7]);
                        fmt = __builtin_bit_cast(bf16x8, mu_); }
#pragma unroll 1
                    for (int nt = 0; nt < 4; ++nt) {
                        const float ecn = *(const LAS float*)(scr + O_ECL + (16 * nt + c16) * 4);
                        const bf16x8 fb = (q4 < 2) ? *(const LAS bf16x8*)(scr + O_XB + (16 * nt + c16) * 32 + 16 * q4) : zf;
                        const f32x4 z4 = (f32x4){0.f, 0.f, 0.f, 0.f};
                        f32x4 gt[4], hm;
#pragma unroll
                        for (int mt2 = 0; mt2 < 4; ++mt2) gt[mt2] = __builtin_amdgcn_mfma_f32_16x16x32_bf16(fat[mt2], fb, z4, 0, 0, 0);
                        hm = __builtin_amdgcn_mfma_f32_16x16x32_bf16(fmt, fb, z4, 0, 0, 0);
#pragma unroll
                        for (int mt2 = 0; mt2 < 4; ++mt2)
#pragma unroll
                            for (int r_ = 0; r_ < 4; ++r_) gt[mt2][r_] *= ecn;
#pragma unroll
                        for (int r_ = 0; r_ < 4; ++r_) { if (4 * q4 + r_ == c16) gt[nt][r_] += ecn; hm[r_] = (hm[r_] + XV(O_XK, 4 * q4 + r_, 16 * nt + c16)) * ecn; }
#pragma unroll
                        for (int s2 = 0; s2 < 2; ++s2) { u32x4 o; o.x = pg8::cvt_pk_bf16(gt[2 * s2][0], gt[2 * s2][1]); o.y = pg8::cvt_pk_bf16(gt[2 * s2][2], gt[2 * s2][3]); o.z = pg8::cvt_pk_bf16(gt[2 * s2 + 1][0], gt[2 * s2 + 1][1]); o.w = pg8::cvt_pk_bf16(gt[2 * s2 + 1][2], gt[2 * s2 + 1][3]);
                            *(u32x4*)(opsb + (size_t)mt * OPB + (nt * 2 + s2) * 1024 + lane * 16) = o; }
                        *(u32x2*)(opsb + (size_t)mt * OPB + 10240 + nt * 512 + lane * 8) = (u32x2){pg8::cvt_pk_bf16(hm[0], hm[1]), pg8::cvt_pk_bf16(hm[2], hm[3])};
                    }
                }
                LFENCE();
#undef AT_A
#undef LFENCE
#undef SM_MUL
#undef XV
#undef SM_B
#undef SM_A
#undef SM_WR
                __syncthreads();
            }
#undef PREP_LOAD
        }
#undef PREP_ATILE
        __syncthreads();
        const int lane_b = pg8::lane_now();
        {
            const int lane = lane_b;
            const float lg_ = lng[64 * w + lane], lb_ = lnb[64 * w + lane];
            LAS unsigned char* vrow = lds + w * VWAVE + lane * VST;
            const bf16_t* pv = Pp + (size_t)m0 * INC + RWC + CW + 64 * w + lane;
            bf16_t raw[8], nraw[8];
#pragma unroll
            for (int s = 0; s < 8; ++s) raw[s] = pv[(size_t)s * INC];
            for (int sb = 0; sb < 16; ++sb) {
                if (sb + 1 < 16) {
#pragma unroll
                    for (int s = 0; s < 8; ++s) nraw[s] = pv[(size_t)((sb + 1) * 8 + s) * INC];
                }
                float vn[8];
#pragma unroll
                for (int s = 0; s < 8; ++s) {
                    const float z = fast_gelu(bf2f(raw[s]));
                    const float mean = red64(z) * (1.f / 64.f); const float d = z - mean;
                    const float var = red64(d * d) * (1.f / 64.f);
                    vn[s] = d * rsqrtf(var + 1e-5f) * lg_ + lb_;
                }
                u32x4 o; o.x = pg8::cvt_pk_bf16(vn[0], vn[1]); o.y = pg8::cvt_pk_bf16(vn[2], vn[3]); o.z = pg8::cvt_pk_bf16(vn[4], vn[5]); o.w = pg8::cvt_pk_bf16(vn[6], vn[7]);
                *(LAS u32x4*)(vrow + sb * 16) = o;
#pragma unroll
                for (int s = 0; s < 8; ++s) raw[s] = nraw[s];
            }
        }
        asm volatile("s_waitcnt lgkmcnt(0)" ::: "memory");
        {
            const int c16 = lane_b & 15, q4 = lane_b >> 4;
            const float* wsg = wsp + (size_t)w * 16384;
            const LAS unsigned char* vb = lds + w * VWAVE + 16 * q4;
            for (int mt = 0; mt < 8; ++mt) {
                f32x4 acc[4];
#pragma unroll
                for (int j = 0; j < 4; ++j) acc[j] = (f32x4){0.f, 0.f, 0.f, 0.f};
                const int t_a = 16 * mt + c16;
                uint2 pu[4]; float bias[4];
#pragma unroll
                for (int rr = 0; rr < 4; ++rr) { const int tl = 16 * mt + 4 * q4 + rr; pu[rr] = *(const uint2*)(Pp + (size_t)(m0 + tl) * INC + RWC + 64 * w + 4 * c16); bias[rr] = bsp[w * 128 + tl]; }
                f32x4 x0[4], x1[4];
#pragma unroll
                for (int ks = 0; ks < 4; ++ks) if (ks <= mt / 2) { const int s0 = 32 * ks + 8 * q4; x0[ks] = *(const f32x4*)(wsg + (size_t)t_a * 128 + s0); x1[ks] = *(const f32x4*)(wsg + (size_t)t_a * 128 + s0 + 4); }
#pragma unroll
                for (int ks = 0; ks < 4; ++ks) if (ks <= mt / 2) {
                    const int s0 = 32 * ks + 8 * q4;
                    float xv[8] = {x0[ks][0], x0[ks][1], x0[ks][2], x0[ks][3], x1[ks][0], x1[ks][1], x1[ks][2], x1[ks][3]};
#pragma unroll
                    for (int e = 0; e < 8; ++e) if (s0 + e > t_a) xv[e] = 0.f;
                    u32x4 au; au.x = pg8::cvt_pk_bf16(xv[0], xv[1]); au.y = pg8::cvt_pk_bf16(xv[2], xv[3]); au.z = pg8::cvt_pk_bf16(xv[4], xv[5]); au.w = pg8::cvt_pk_bf16(xv[6], xv[7]);
                    const bf16x8 af = __builtin_bit_cast(bf16x8, au);
#pragma unroll
                    for (int j = 0; j < 4; ++j) { const bf16x8 bfr = *(const LAS bf16x8*)(vb + (4 * c16 + j) * VST + ks * 64); acc[j] = __builtin_amdgcn_mfma_f32_16x16x32_bf16(af, bfr, acc[j], 0, 0, 0); }
                }
#pragma unroll
                for (int rr = 0; rr < 4; ++rr) {
                    const int m = m0 + 16 * mt + 4 * q4 + rr;
                    const float u0 = fast_gelu(pg8::bflo(pu[rr].x)), u1 = fast_gelu(pg8::bfhi(pu[rr].x)), u2 = fast_gelu(pg8::bflo(pu[rr].y)), u3 = fast_gelu(pg8::bfhi(pu[rr].y));
                    if constexpr (MRG_F8) *(unsigned*)((unsigned char*)O + (size_t)m * D + CW + 64 * w + 4 * c16) = (unsigned)pk4_fp8(u0 * (acc[0][rr] + bias[rr]) * OGM_SCALE, u1 * (acc[1][rr] + bias[rr]) * OGM_SCALE, u2 * (acc[2][rr] + bias[rr]) * OGM_SCALE, u3 * (acc[3][rr] + bias[rr]) * OGM_SCALE);
                    else { uint2 ov; ov.x = pg8::cvt_pk_bf16(u0 * (acc[0][rr] + bias[rr]), u1 * (acc[1][rr] + bias[rr])); ov.y = pg8::cvt_pk_bf16(u2 * (acc[2][rr] + bias[rr]), u3 * (acc[3][rr] + bias[rr]));
                    *(uint2*)(O + (size_t)m * D + CW + 64 * w + 4 * c16) = ov; }
                }
            }
        }
        __syncthreads();
    }
}

__device__ __forceinline__ void f_post(const Params& P, const Ctx& c) {
    const bf16_t* V = (const bf16_t*)(P.ws + WS_SCANV); const float* Y = (const float*)(P.ws + WS_Y); const float* Gb = (const float*)(P.ws + WS_G);
    const float* bonus = (const float*)(P.ws + WS_BONUS); const float *lg = P.in[15], *lb = P.in[16];
    bf16_t* O = (bf16_t*)(P.ws + WS_O);
    const int l16 = c.lane & 15, sub = c.lane >> 4;
    u32x2 ny, ng, nv; float nb;
    { const int m = c.gwave >> 1, h = (c.gwave & 1) * 4 + sub; const unsigned ob = (unsigned)(m * CW + h * 64 + 4 * l16) * 2u;
      ny = *(const u32x2*)((const char*)Y + ob); ng = *(const u32x2*)((const char*)Gb + ob); nv = *(const u32x2*)((const char*)V + ob); nb = bonus[m * 8 + h]; }
    for (int it = c.gwave; it < NTOK * 2; it += c.nwaves) {
        const int m = it >> 1, h = (it & 1) * 4 + sub, col = h * 64 + 4 * l16;
        const u32x2 yb_ = ny, gb_ = ng, vb_ = nv; const float bn = nb;
        if (it + c.nwaves < NTOK * 2) { const int it2 = it + c.nwaves, m2 = it2 >> 1, h2 = (it2 & 1) * 4 + sub; const unsigned ob = (unsigned)(m2 * CW + h2 * 64 + 4 * l16) * 2u;
            ny = *(const u32x2*)((const char*)Y + ob); ng = *(const u32x2*)((const char*)Gb + ob); nv = *(const u32x2*)((const char*)V + ob); nb = bonus[m2 * 8 + h2]; }
        const f32x4 yv = (f32x4){pg8::bflo(yb_[0]), pg8::bfhi(yb_[0]), pg8::bflo(yb_[1]), pg8::bfhi(yb_[1])}, gv = (f32x4){pg8::bflo(gb_[0]), pg8::bfhi(gb_[0]), pg8::bflo(gb_[1]), pg8::bfhi(gb_[1])};
        const f32x4 vv = (f32x4){pg8::bflo(vb_[0]), pg8::bfhi(vb_[0]), pg8::bflo(vb_[1]), pg8::bfhi(vb_[1])};
        const f32x4 lgv = *(const f32x4*)(lg + col), lbv = *(const f32x4*)(lb + col);
        const float mean = red16((yv[0] + yv[1]) + (yv[2] + yv[3])) * (1.f / 64.f);
        const f32x4 d = yv - mean;
        const float var = red16((d[0] * d[0] + d[1] * d[1]) + (d[2] * d[2] + d[3] * d[3])) * (1.f / 64.f);
        const float rs = rsqrtf(var + 64e-5f);
        float o[4];
#pragma unroll
        for (int j = 0; j < 4; ++j) o[j] = (d[j] * rs * lgv[j] + lbv[j] + bn * vv[j]) * gv[j];
        if constexpr (MRG_F8) *(unsigned*)((unsigned char*)O + (size_t)m * D + col) = (unsigned)pk4_fp8(o[0] * ORW_SCALE, o[1] * ORW_SCALE, o[2] * ORW_SCALE, o[3] * ORW_SCALE);
        else { uint2 ov; ov.x = pg8::cvt_pk_bf16(o[0], o[1]); ov.y = pg8::cvt_pk_bf16(o[2], o[3]);
        *(uint2*)(O + (size_t)m * D + col) = ov; }
    }
}

__global__ void __launch_bounds__(NT) fwd_kernel(Params P) {
    cg::grid_group grid = cg::this_grid();
#define MKTID() ({ int l_; asm volatile("v_mbcnt_lo_u32_b32 %0, -1, 0\n\tv_mbcnt_hi_u32_b32 %0, -1, %0" : "=v"(l_)); const int t_ = (s_wave << 6) | l_; t_; })
#define MKCTX() ({ Ctx c_; const int t_ = MKTID(); c_.tid = t_; c_.gtid = (long)blockIdx.x * NT + t_; c_.gthreads = (long)gridDim.x * NT; c_.gwave = (int)(c_.gtid >> 6); c_.nwaves = (int)(c_.gthreads >> 6); c_.lane = t_ & 63; c_; })
    bf16_t* H = (bf16_t*)(P.ws + WS_H); bf16_t* Pp = (bf16_t*)(P.ws + WS_P);
    const float* mod = (const float*)(P.ws + WS_MOD);
    extern __shared__ __attribute__((aligned(16))) unsigned char lds_raw[];
    LAS unsigned char* lds = (LAS unsigned char*)lds_raw;
    const int s_wave = __builtin_amdgcn_readfirstlane(threadIdx.x >> 6);
    LAS float* scr = (LAS float*)(lds + s_wave * 16384);
    volatile LAS unsigned* bst = (volatile LAS unsigned*)(lds + 131072 + 16384 + 7168);
    if (threadIdx.x == 0) { bst[0] = 0u; bst[1] = 0u; }
    __syncthreads();
    const XcdBarrier xbar = xcd_barrier_post((unsigned*)(P.ws + WS_CTL), bst, (int)threadIdx.x);
#define GSYNC() xcd_barrier(xbar, MKTID())
#define PH(k) for (int rep_ = 0; rep_ < (((PROBE_MASK >> (k)) & 1) ? PROBE_N : 1); ++rep_)

    PH(0) { f_mod(P, lds, MKTID()); __syncthreads(); }
    PH(1) { transpose_small(P, scr, MKCTX()); __syncthreads(); }
    if (P.ws == nullptr) grid.sync();
    GSYNC();
    PH(2) n_norm<(PG_F8 ? 2 : 0), false>(P, MKCTX(), P.in[0], P.in[4], 0, 1);
    GSYNC();
    PH(3) {
        pg8::DenseSched S; S.init(NTOK, INC, D, gridDim.x, blockIdx.x, P.ws + WS_WTIN, PG_F8 ? 1 : 2);
        pg8::EpiP E{Pp, INC};
        pg8::gemm_phase<pg8::EpiP, pg8::DenseSched, true, PG_F8>(lds, (const char*)H, D, S, E, MKTID());
    }
    GSYNC();
    PH(4) f_prep_gmlp(P, lds, MKTID());
    GSYNC();
    PH(5) {
        if (blockIdx.x < NB * 8) f_scan(P, lds, MKTID());
        else {
            Ctx c_ = MKCTX(); c_.gwave -= NB * 8 * (NT / 64); c_.nwaves -= NB * 8 * (NT / 64);
            transpose_moe(P, lds, s_wave, c_);
        }
    }
    GSYNC();
    PH(6) f_post(P, MKCTX());
    GSYNC();
    PH(8) {
        pg8::DenseSched S; S.init(NTOK, D, D, gridDim.x, blockIdx.x, P.ws + WS_WTBR, MRG_F8 ? 1 : 2);
        pg8::EpiMerge E{Pp, (bf16_t*)(P.ws + WS_Y)};
        pg8::gemm_phase<pg8::EpiMerge, pg8::DenseSched, true, MRG_F8>(lds, (const char*)(P.ws + WS_O), D, S, E, MKTID());
    }
    GSYNC();
    PH(9) {
        pg8::DenseSched S; S.init(NTOK, D, D, gridDim.x, blockIdx.x, P.ws + WS_WTOUT, OUT_F8 ? 1 : 2);
        pg8::EpiOut E{P.in[0], mod, (bf16_t*)(P.ws + WS_X1)};
        pg8::gemm_phase<pg8::EpiOut, pg8::DenseSched, true, OUT_F8>(lds, (const char*)(P.ws + WS_Y), D, S, E, MKTID());
    }
    GSYNC();
    PH(10) n_norm<(MOE1_F8 ? 1 : 0), true>(P, MKCTX(), P.ws + WS_X1, P.in[24], 3, 4);
    GSYNC();
    PH(11) {
        const int half = (int)gridDim.x >> 1;
        if ((int)blockIdx.x < half) {
            pg8::DenseSched S; S.init(NTOK, NE, D, half, blockIdx.x, P.ws + WS_WTRS);
            pg8::EpiRouter E{(float*)(P.ws + WS_G)};
            pg8::gemm_phase<pg8::EpiRouter, pg8::DenseSched, true>(lds, (const char*)H, D, S, E, MKTID());
        } else {
            pg8::DenseSched S; S.init(NTOK, 2 * ED, D, half, (int)blockIdx.x - half, P.ws + WS_WTRS + 512 * 1024, 1);
            pg8::EpiShared E{(bf16_t*)(P.ws + WS_ACTSH)};
            pg8::gemm_phase<pg8::EpiShared, pg8::DenseSched, true, true>(lds, (const char*)(P.ws + WS_H2F8), D, S, E, MKTID());
        }
    }
    GSYNC();
    PH(12) f_topk(P, (int*)(lds_raw + 131072 + 16384), MKTID());
    GSYNC();
    PH(13) f_route2(P, (int*)(lds_raw + 131072 + 16384), MKTID());
    GSYNC();
    PH(14) {
        const int* tile_e = (const int*)(P.ws + WS_TILE); const int ntiles = __builtin_amdgcn_readfirstlane(tile_e[6144]);
        pg8::MoeSched1 S{(const int*)(P.ws + WS_ROWTOK), tile_e, ntiles * 2, (int)gridDim.x, (int)blockIdx.x, (const char*)(P.ws + WS_WTGU)};
        pg8::EpiMoe1 E{(bf16_t*)(P.ws + WS_ACTP)};
        pg8::gemm_phase<pg8::EpiMoe1, pg8::MoeSched1, true, MOE1_F8>(lds, MOE1_F8 ? (const char*)(P.ws + WS_H2F8) : (const char*)H, D, S, E, MKTID());
    }
    GSYNC();
    PH(15) {
        const int* tile_e = (const int*)(P.ws + WS_TILE); const int ntiles = __builtin_amdgcn_readfirstlane(tile_e[6144]);
        pg8::MoeSched2 S{tile_e, ntiles * 4, (int)gridDim.x, (int)blockIdx.x, (const char*)(P.ws + WS_WTDN)};
        pg8::EpiMoe2 E{(bf16_t*)(P.ws + WS_YS), (const float*)(P.ws + WS_ROWW), P.ws + WS_G + (size_t)blockIdx.x * 1024};
        pg8::gemm_phase<pg8::EpiMoe2, pg8::MoeSched2, true, true>(lds, (const char*)(P.ws + WS_ACTP), ED, S, E, MKTID());
    }
    PH(16) {
        pg8::DenseSched S2; S2.init(NTOK, D, ED, gridDim.x, blockIdx.x, P.ws + WS_WTSHD);
        pg8::EpiYsh E2{(bf16_t*)(P.ws + WS_YSH)};
        pg8::gemm_phase<pg8::EpiYsh, pg8::DenseSched, true>(lds, (const char*)(P.ws + WS_ACTSH), ED, S2, E2, MKTID());
    }
    GSYNC();
    f_final(P, MKCTX());
}

extern "C" void kernel_launch(void* const* d_in, const int* in_sizes, int n_in, void* d_out, int out_size, void* d_ws, size_t ws_size, hipStream_t stream) {
    static int grid_blocks = 0;
    if (!grid_blocks) {
        int dev = 0, cus = 0, per_cu = 0;
        hipGetDevice(&dev);
        hipDeviceGetAttribute(&cus, hipDeviceAttributeMultiprocessorCount, dev);
        if (hipFuncSetAttribute((const void*)fwd_kernel, hipFuncAttributeMaxDynamicSharedMemorySize, LDS_BYTES) != hipSuccess) fprintf(stderr, "kernel_launch: hipFuncSetAttribute failed\n");
        if (hipOccupancyMaxActiveBlocksPerMultiprocessor(&per_cu, fwd_kernel, NT, LDS_BYTES) != hipSuccess || per_cu < 1) { fprintf(stderr, "kernel_launch: occupancy query says %d\n", per_cu); per_cu = 1; }
        (void)hipGetLastError();
        grid_blocks = cus;
        if (n_in != 34 || ws_size < WS_END) fprintf(stderr, "kernel_launch: unexpected n_in %d or ws_size %zu\n", n_in, ws_size);
    }
    (void)hipMemsetAsync((char*)d_ws + WS_CTL, 0, 65536, stream);
    Params p{};
    for (int i = 0; i < 34; ++i) p.in[i] = (const float*)d_in[i];
    p.out = (float*)d_out; p.ws = (unsigned char*)d_ws;
    void* args[] = {&p};
    hipError_t e = hipLaunchCooperativeKernel((void*)fwd_kernel, dim3(grid_blocks), dim3(NT), args, LDS_BYTES, stream);
    if (e != hipSuccess) fprintf(stderr, "cooperative launch failed: %s (grid %d)\n", hipGetErrorString(e), grid_blocks);
}
```

```cpp
#include <hip/hip_runtime.h>
#include <hip/hip_cooperative_groups.h>
#include <cstdio>
#include <cstdint>
namespace cg = cooperative_groups;

typedef unsigned short bf16_t;
__device__ __forceinline__ float bf2f(bf16_t v) { return __uint_as_float((unsigned)v << 16); }
__device__ __forceinline__ bf16_t f2bf(float f) { unsigned u = __float_as_uint(f); return (bf16_t)((u + 0x7fffu + ((u >> 16) & 1u)) >> 16); }

constexpr int NB = 8, SEQ = 4096, D = 1024, NTOK = NB * SEQ;
constexpr int CW = 512;
constexpr int RWC = 1792, INC = 4864, GT_OFF = 2816;
constexpr int NE = 256, TOPK = 8, ED = 256;
constexpr int NPAIR = NTOK * TOPK;
#ifndef PROBE_MASK
#define PROBE_MASK 0
#define PROBE_N 1
#endif
constexpr bool MOE1_F8 = true;
constexpr bool OUT_F8 = true;
constexpr float MRG_SCALE = 32.f;
constexpr bool MRG_F8 = true;
constexpr float ORW_SCALE = 16.f, OGM_SCALE = 8.f;
constexpr int CONV_EARLY = 2048;
constexpr bool PG_F8 = true;
constexpr float YS_SCALE = 16.f;
constexpr int NT = 512;
constexpr int LDS_BYTES = 155648;

constexpr size_t MiB = 1u << 20;
constexpr size_t WS_CTL = 0;
constexpr size_t WS_MOD = 1 * MiB;
constexpr size_t WS_BONUS = 2 * MiB;
constexpr size_t WS_TOKE = 3 * MiB;
constexpr size_t WS_TOKW = 4 * MiB;
constexpr size_t WS_TILE = 512 * 1024;
constexpr size_t WS_LORA = 768 * 1024;
constexpr size_t WS_BLKCNT = 5 * MiB;
constexpr size_t WS_TOKLP = 6 * MiB;
constexpr size_t WS_TOKDEST = 7 * MiB;
constexpr size_t WS_ROWTOK = 8 * MiB;
constexpr size_t WS_ROWW = 10 * MiB;
constexpr size_t WS_BK2 = 8 * MiB;
constexpr size_t WS_WTIN = 12 * MiB;
constexpr size_t WS_WTBR = 22 * MiB;
constexpr size_t WS_WTOUT = 24 * MiB;
constexpr size_t WS_WTRS = 26 * MiB;
constexpr size_t WS_WTSHD = 27 * MiB + 512 * 1024;
constexpr size_t WS_WTDN = 28 * MiB;
constexpr size_t WS_WTGU = 156 * MiB;
constexpr size_t WS_YS = 156 * MiB;
constexpr size_t WS_YSH = 844 * MiB;
constexpr size_t WS_X1 = 476 * MiB;
constexpr size_t WS_H2F8 = 972 * MiB;
constexpr size_t WS_ACTP = 668 * MiB;
constexpr size_t WS_SCANV = 437 * MiB;
constexpr size_t OPS_BH = (size_t)(SEQ / 16) * 12800;
constexpr int OPB = 12800;
constexpr size_t WS_H = 412 * MiB;
constexpr size_t WS_O = 476 * MiB;
constexpr size_t WS_P = 540 * MiB;
constexpr size_t WS_Y = 844 * MiB;
constexpr size_t WS_G = 908 * MiB;
constexpr size_t WS_ACTSH = 940 * MiB;
constexpr size_t WS_VN = WS_H;
constexpr size_t WS_ACT = 668 * MiB;
constexpr size_t WS_END = 1024 * MiB;

__device__ __forceinline__ int pk4_fp8(float a, float b, float c, float d) {
    a = __builtin_fminf(__builtin_fmaxf(a, -448.f), 448.f); b = __builtin_fminf(__builtin_fmaxf(b, -448.f), 448.f); c = __builtin_fminf(__builtin_fmaxf(c, -448.f), 448.f); d = __builtin_fminf(__builtin_fmaxf(d, -448.f), 448.f);
    int r = __builtin_amdgcn_cvt_pk_fp8_f32(a, b, 0, false); return __builtin_amdgcn_cvt_pk_fp8_f32(c, d, r, true);
}
struct Params {
    const float* in[34];
    float* out;
    unsigned char* ws;
};

__device__ __forceinline__ unsigned char* ops_ptr(const Params& P, int bh) {
    return bh < 40 ? (unsigned char*)P.out + (size_t)bh * OPS_BH : (bh < 56 ? P.ws + 972 * MiB + (size_t)(bh - 40) * OPS_BH : P.ws + 412 * MiB + (size_t)(bh - 56) * OPS_BH);
}
__device__ __forceinline__ float wave_sum(float v) {
#pragma unroll
    for (int o = 32; o; o >>= 1) v += __shfl_xor(v, o);
    return v;
}
__device__ __forceinline__ float sigmoidf_(float x) { return 1.f / (1.f + expf(-x)); }
__device__ __forceinline__ float siluf_(float x) { return x / (1.f + expf(-x)); }
__device__ __forceinline__ float geluf_(float x) { return 0.5f * x * (1.f + tanhf(0.7978845608028654f * (x + 0.044715f * x * x * x))); }

struct Ctx { long gtid, gthreads; int gwave, nwaves, lane, tid; };

template <int MODE, bool XBF16>
__device__ __forceinline__ void n_norm(const Params& P, const Ctx& c, const void* xin, const float* g, int sh_idx, int sc_idx) {
    typedef float f32x4_ __attribute__((ext_vector_type(4)));
    typedef unsigned u32x2_ __attribute__((ext_vector_type(2)));
    const float* mod = (const float*)(P.ws + WS_MOD);
    bf16_t* H = (bf16_t*)(P.ws + WS_H);
    for (int m = c.gwave; m < NTOK; m += c.nwaves) {
        f32x4_ v[4]; float ss = 0.f;
#pragma unroll
        for (int i = 0; i < 4; ++i) {
            if (XBF16) { const u32x2_ r_ = *(const u32x2_*)((const bf16_t*)xin + (size_t)m * D + 4 * c.lane + 256 * i); v[i] = (f32x4_){__uint_as_float(r_[0] << 16), __uint_as_float(r_[0] & 0xffff0000u), __uint_as_float(r_[1] << 16), __uint_as_float(r_[1] & 0xffff0000u)}; }
            else v[i] = *(const f32x4_*)((const float*)xin + (size_t)m * D + 4 * c.lane + 256 * i);
            ss += (v[i][0] * v[i][0] + v[i][1] * v[i][1]) + (v[i][2] * v[i][2] + v[i][3] * v[i][3]); }
        ss = wave_sum(ss);
        const float rstd = rsqrtf(ss * (1.f / D) + 1e-6f);
        const float* mb = mod + (size_t)(m / SEQ) * 6 * D;
#pragma unroll
        for (int i = 0; i < 4; ++i) { const int j = 4 * c.lane + 256 * i;
            const f32x4_ gv = *(const f32x4_*)(g + j), scv = *(const f32x4_*)(mb + sc_idx * D + j), shv = *(const f32x4_*)(mb + sh_idx * D + j);
            float hv[4];
#pragma unroll
            for (int q = 0; q < 4; ++q) hv[q] = v[i][q] * rstd * gv[q] * (1.f + scv[q]) + shv[q];
            if (MODE != 2) *(u32x2_*)(H + (size_t)m * D + j) = (u32x2_){(unsigned)f2bf(hv[0]) | ((unsigned)f2bf(hv[1]) << 16), (unsigned)f2bf(hv[2]) | ((unsigned)f2bf(hv[3]) << 16)};
            if (MODE != 0) { const int pk = pk4_fp8(hv[0] * 2.f, hv[1] * 2.f, hv[2] * 2.f, hv[3] * 2.f);
                *(int*)(P.ws + (MODE == 1 ? WS_H2F8 : WS_H) + (size_t)m * D + j) = pk; }
        }
    }
}

#define LAS __attribute__((address_space(3)))
typedef short bf16x8 __attribute__((ext_vector_type(8)));
typedef float f32x4 __attribute__((ext_vector_type(4)));
typedef unsigned u32x4 __attribute__((ext_vector_type(4)));
typedef unsigned u32x2 __attribute__((ext_vector_type(2)));
typedef int i32x8 __attribute__((ext_vector_type(8)));
typedef int i32x4 __attribute__((ext_vector_type(4)));
namespace pg8 {
constexpr int BM = 256, BK = 64, HALF = 128, HTB = HALF * BK * 2, STAGE_BYTES = 8 * HTB, NXCD = 8, WGM = 8;
constexpr unsigned PRE_OFF = STAGE_BYTES + 10 * 2048;
__device__ __forceinline__ int lds_byte(int r, int c) { const int st = (r >> 4) * 2 + (c >> 5), rr = r & 15, cc = c & 31, ob = rr * 64 + cc * 2; return st * 1024 + (ob ^ (((ob >> 9) & 1) << 5)); }
__device__ __forceinline__ void stage_rc(int b, int& R, int& C) { const int st = b / 1024, sb = b % 1024, swz = sb ^ (((sb >> 9) & 1) << 5); R = (st >> 1) * 16 + swz / 64; C = (st & 1) * 32 + (swz % 64) / 2; }
__device__ __forceinline__ int perm32(int rho) { const int n = rho >> 4, i = rho & 15; return 8 * (i >> 2) + 4 * n + (i & 3); }
__device__ __forceinline__ unsigned cvt_pk_bf16(float lo, float hi) { unsigned r; asm volatile("v_cvt_pk_bf16_f32 %0, %1, %2" : "=v"(r) : "v"(lo), "v"(hi)); return r; }

__device__ __forceinline__ int lane_now() { int l_; asm volatile("v_mbcnt_lo_u32_b32 %0, -1, 0\n\tv_mbcnt_hi_u32_b32 %0, -1, %0" : "=v"(l_)); return l_; }
struct Unit { int pm, pn, aux, aux2; };
__device__ __forceinline__ const int* uni_ptr(const int* p) { const unsigned long g_ = (unsigned long)p; return (const int*)(((unsigned long)(unsigned)__builtin_amdgcn_readfirstlane((int)(g_ >> 32)) << 32) | (unsigned long)(unsigned)__builtin_amdgcn_readfirstlane((int)g_)); }
__device__ __forceinline__ int sload1(const int* p) { int v; asm volatile("s_load_dword %0, %1, 0x0\n\ts_waitcnt lgkmcnt(0)" : "=s"(v) : "s"(uni_ptr(p)) : "memory"); return v; }
__device__ __forceinline__ void sload3(const int* p0, const int* p1, const int* p2, int& a, int& b, int& c) {
    asm volatile("s_load_dword %0, %3, 0x0\n\ts_load_dword %1, %4, 0x0\n\ts_load_dword %2, %5, 0x0\n\ts_waitcnt lgkmcnt(0)" : "=&s"(a), "=&s"(b), "=&s"(c) : "s"(uni_ptr(p0)), "s"(uni_ptr(p1)), "s"(uni_ptr(p2)) : "memory"); }

struct DenseSched {
    int nM, nN, nwg, G, c, K; const char* Bt;
    __device__ void init(int M, int N, int K_, int G_, int c_, const void* Bt_, int esz = 2) { nM = M / BM; nN = N / BM; nwg = nM * nN; G = G_; c = c_; K = K_ * esz; Bt = (const char*)Bt_; }
    __device__ __forceinline__ bool next(int i, Unit& u) const {
        const long L = (long)i * G + c; if (L >= nwg) return false;
        int wgid = (int)L; { const int q = nwg / NXCD, r = nwg % NXCD, xcd = wgid % NXCD, off = wgid / NXCD; wgid = (xcd < r ? xcd * (q + 1) : r * (q + 1) + (xcd - r) * q) + off; }
        const int nig = WGM * nN, gid = wgid / nig, fm = gid * WGM, gsz = (nM - fm) < WGM ? (nM - fm) : WGM;
        u.pm = fm + ((wgid % nig) % gsz); u.pn = (wgid % nig) / gsz; u.aux = 0; u.aux2 = 0; return true;
    }
    __device__ __forceinline__ unsigned a_off(const Unit& u, int r) const { return (unsigned)(u.pm * BM + r) * (unsigned)K; }
    __device__ __forceinline__ const char* b_ptr(const Unit& u) const { return Bt + (size_t)u.pn * BM * K; }
};

template <class Epi, class Sched, bool ALIGN_EPI, bool F8 = false>
__device__ __forceinline__ void gemm_phase(LAS unsigned char* lds, const char* Abase, const int K, const Sched& S, const Epi& E, int tid) {
    asm volatile("" : "+v"(tid));
    const int wid = __builtin_amdgcn_readfirstlane(tid >> 6), lane = tid & 63, wr = wid >> 2, wc = wid & 3, fr = lane & 15, fq = lane >> 4;
    const int nt = F8 ? K / 128 : K / BK;
    unsigned voffB_[2];
#pragma unroll
    for (int i = 0; i < 2; ++i) { int sR, sC; stage_rc(tid * 16 + i * 8192, sR, sC); const int Rb = Epi::PERM ? ((sR & ~31) + perm32(sR & 31)) : sR; voffB_[i] = F8 ? (unsigned)(Rb * K + sC * 2) : (unsigned)(Rb * K + sC) * 2u; }
    const size_t kstep = (size_t)(BK * 2);
    const size_t hstepB = (size_t)HALF * K * (F8 ? 1 : 2);
    const unsigned ldsw = (unsigned)wid * 1024u;
    const unsigned slotaddr = (unsigned)(unsigned long)lds + (unsigned)STAGE_BYTES + (unsigned)tid * 4u;
    const unsigned ldsbase = (unsigned)(unsigned long)lds;
    const int lp = F8 ? lds_byte(fr, 32 * (fq >> 1) + 16 * (fq & 1)) + 16 * (fq & 1) : lds_byte(fr, fq * 8);
    const unsigned aU = (unsigned)(unsigned long)lds + (unsigned)wr * 8192u, bU = (unsigned)(unsigned long)lds + (unsigned)wc * 4096u;
    volatile LAS unsigned* myslot = (volatile LAS unsigned*)(lds + STAGE_BYTES) + tid;
    myslot[8 * 512] = voffB_[0]; myslot[9 * 512] = voffB_[1];
    struct VB_ { volatile LAS unsigned* p; __device__ __forceinline__ unsigned operator[](int i) const { return p[(8 + i) * 512]; } } voffB{myslot};
#define PG8_FILL(par, u) do { const int _t = (wid << 6) | lane_now(); _Pragma("unroll") for (int _i = 0; _i < 2; ++_i) { int _R, _C; stage_rc(_t * 16 + _i * 8192, _R, _C); \
        _Pragma("unroll") for (int _h = 0; _h < 2; ++_h) myslot[((par) * 4 + _h * 2 + _i) * 512] = S.a_off(u, _h * HALF + _R) + (unsigned)_C * 2u; } } while (0)
#define PG8_SA(b, h) (((b) * 2 + (h)) * HTB)
#define PG8_SB(b, h) ((4 + (b) * 2 + (h)) * HTB)
#define PG8_STAGE(bufoff, gbase, voff) do { _Pragma("unroll") for (int _i = 0; _i < 2; ++_i) \
        __builtin_amdgcn_global_load_lds((const unsigned*)((const char*)(gbase) + (voff)[_i]), (LAS unsigned*)(lds + (bufoff) + ldsw + _i * 8192), 16, 0, 0); } while (0)
#define PG8_STAGE_A(bufoff, gbase, par, h) do { _Pragma("unroll") for (int _i = 0; _i < 2; ++_i) { const unsigned _o = myslot[((par) * 4 + (h) * 2 + _i) * 512]; \
        __builtin_amdgcn_global_load_lds((const unsigned*)((const char*)(gbase) + _o), (LAS unsigned*)(lds + (bufoff) + ldsw + _i * 8192), 16, 0, 0); } } while (0)
#define PG8_RD(dst, par, e) asm volatile("v_lshl_add_u32 %0, %2, 13, %1\n\tds_read_b32 %0, %0 offset:%3" : "=&v"(dst) : "v"(slotaddr), "s"((unsigned)(par)), "n"((e) * 2048) : "memory")
#define PG8_DMA1(ldsaddr, gbase, off) asm volatile("s_mov_b32 m0, %0\n\ts_nop 0\n\tglobal_load_lds_dwordx4 %1, %2" :: "s"(ldsaddr), "v"(off), "s"(gbase) : "memory", "m0")
#define PG8_STAGE_O(bufoff, gbase, o0, o1) do { const unsigned _la = ldsbase + (unsigned)(bufoff) + ldsw; const unsigned long _g = (unsigned long)(gbase); const char* _gb = (const char*)(((unsigned long)(unsigned)__builtin_amdgcn_readfirstlane((int)(_g >> 32)) << 32) | (unsigned long)(unsigned)__builtin_amdgcn_readfirstlane((int)_g)); PG8_DMA1(_la, _gb, o0); PG8_DMA1(_la + 8192u, _gb, o1); } while (0)
#define PG8_STAGE_B(bufoff, gbase, o0) do { const unsigned _la = ldsbase + (unsigned)(bufoff) + ldsw; const unsigned long _g = (unsigned long)(gbase); const char* _gb = (const char*)(((unsigned long)(unsigned)__builtin_amdgcn_readfirstlane((int)(_g >> 32)) << 32) | (unsigned long)(unsigned)__builtin_amdgcn_readfirstlane((int)_g)); PG8_DMA1(_la, _gb, o0); PG8_DMA1(_la + 8192u, _gb + (hstepB >> 1), o0); } while (0)
#define PG8_LDA(dst, b, h) do { unsigned a0_, a1_; asm volatile("v_add_u32 %0, %1, %2" : "=v"(a0_) : "s"(aU + (unsigned)PG8_SA(b, h)), "v"(lp)); a1_ = a0_; if constexpr (F8) asm volatile("v_xor_b32 %0, 16, %0" : "+v"(a1_)); _Pragma("unroll") for (int m = 0; m < 4; ++m) _Pragma("unroll") for (int k = 0; k < 2; ++k) dst[m][k] = *(const LAS bf16x8*)(unsigned long)((F8 ? (k ? a1_ : a0_) : a0_ + k * 1024) + m * 2048); } while (0)
#define PG8_LDB(dst, b, h) do { unsigned b0_, b1_; asm volatile("v_add_u32 %0, %1, %2" : "=v"(b0_) : "s"(bU + (unsigned)PG8_SB(b, h)), "v"(lp)); b1_ = b0_; if constexpr (F8) asm volatile("v_xor_b32 %0, 16, %0" : "+v"(b1_)); _Pragma("unroll") for (int n = 0; n < 2; ++n) _Pragma("unroll") for (int k = 0; k < 2; ++k) dst[n][k] = *(const LAS bf16x8*)(unsigned long)((F8 ? (k ? b1_ : b0_) : b0_ + k * 1024) + n * 2048); } while (0)
#define PG8_MMA(ai, bj, At, Bt) do { __builtin_amdgcn_s_setprio(1); _Pragma("unroll") for (int m = 0; m < 4; ++m) _Pragma("unroll") for (int n = 0; n < 2; ++n) { \
        if constexpr (F8) { acc[ai][bj][m][n] = __builtin_amdgcn_mfma_scale_f32_16x16x128_f8f6f4( \
                __builtin_shufflevector(__builtin_bit_cast(i32x4, Bt[n][0]), __builtin_bit_cast(i32x4, Bt[n][1]), 0, 1, 2, 3, 4, 5, 6, 7), \
                __builtin_shufflevector(__builtin_bit_cast(i32x4, At[m][0]), __builtin_bit_cast(i32x4, At[m][1]), 0, 1, 2, 3, 4, 5, 6, 7), acc[ai][bj][m][n], 0, 0, 0, Epi::SC_W, 0, Epi::SC_X); } \
        else { _Pragma("unroll") for (int k = 0; k < 2; ++k) acc[ai][bj][m][n] = __builtin_amdgcn_mfma_f32_16x16x32_bf16(Bt[n][k], At[m][k], acc[ai][bj][m][n], 0, 0, 0); } } \
        __builtin_amdgcn_s_setprio(0); } while (0)
#define PG8_WAIT_V(n) asm volatile("s_waitcnt vmcnt(" #n ")" ::: "memory")
#define PG8_WAIT_V2(nst) asm volatile("s_waitcnt vmcnt(%0)" :: "n"(8 + (nst)) : "memory")
#define PG8_WAIT_L(n) asm volatile("s_waitcnt lgkmcnt(" #n ")" ::: "memory")
#define PG8_BAR __builtin_amdgcn_s_barrier()
#define PG8_SCHED __builtin_amdgcn_sched_barrier(0)
    Unit cur, nxt; int ui = 0, p3 = 0;
    if (!S.next(0, cur)) return;
    f32x4 acc[2][2][4][2];
#pragma unroll
    for (int a = 0; a < 2; ++a)
#pragma unroll
        for (int b = 0; b < 2; ++b)
#pragma unroll
            for (int m = 0; m < 4; ++m)
#pragma unroll
                for (int n = 0; n < 2; ++n) acc[a][b][m][n] = (f32x4){0.f, 0.f, 0.f, 0.f};
    bf16x8 At[4][2], B0[2][2], B1[2][2];
    PG8_FILL(0, cur);
    if constexpr (Epi::HAS_PRE) E.pre(cur.pm, ldsbase + PRE_OFF, wid);
    const char* cB = S.b_ptr(cur);
    PG8_STAGE(PG8_SB(0, 0), cB, voffB); PG8_STAGE(PG8_SB(0, 1), cB + hstepB, voffB); PG8_STAGE_A(PG8_SA(0, 0), Abase, 0, 0); PG8_STAGE_A(PG8_SA(0, 1), Abase, 0, 1);
    if (wr == 1) PG8_BAR;
    PG8_WAIT_V(2); PG8_BAR;
    PG8_STAGE(PG8_SB(1, 0), cB + kstep, voffB); PG8_STAGE_A(PG8_SA(1, 0), Abase + kstep, 0, 0);
    if constexpr (Epi::NST > 0) PG8_WAIT_V(0); else PG8_WAIT_V(4);
    PG8_BAR;
    for (;;) {
        const bool has_next = S.next(ui + 1, nxt);
        const char* nB = has_next ? S.b_ptr(nxt) : cB;
        const int pc = ui & 1, pn_ = has_next ? (pc ^ 1) : pc;
        const int n3 = (p3 == 2) ? 0 : p3 + 1;
        if (has_next) PG8_FILL(pc ^ 1, nxt);
        if constexpr (Epi::HAS_PRE) E.pre(has_next ? nxt.pm : cur.pm, ldsbase + PRE_OFF + (unsigned)n3 * 1024u, wid);
#define PG8_KITER(t, WAITR) do { \
            const bool last = (t == nt - 2); \
            unsigned tk = (unsigned)t * (unsigned)kstep; asm volatile("" : "+s"(tk)); \
            const char* a1 = Abase + tk + kstep; const char* b1 = cB + tk + kstep; \
            const char* a2 = last ? Abase : Abase + tk + 2 * kstep; const char* b2 = last ? nB : cB + tk + 2 * kstep; \
            const char* a3 = a2 + kstep; const char* b3 = b2 + kstep; \
            const int p2 = last ? pn_ : pc; \
            if constexpr (Epi::HAS_MID) { if (t == nt / 2) { Unit um = cur; asm volatile("" : "+v"(um.pm), "+v"(um.pn)); um.pm = __builtin_amdgcn_readfirstlane(um.pm); um.pn = __builtin_amdgcn_readfirstlane(um.pn); const int l2_ = lane_now(); E.mid(acc, um, wr, wc, l2_ & 15, l2_ >> 4); } } \
            { unsigned ob0, oa0, oa1; PG8_RD(ob0, 0, 8); PG8_RD(oa0, pc, 2); PG8_RD(oa1, pc, 3); \
              PG8_LDB(B0, 0, 0); PG8_LDB(B1, 0, 1); PG8_SCHED; PG8_LDA(At, 0, 0); PG8_SCHED; PG8_WAIT_L(15); PG8_STAGE_B(PG8_SB(1, 1), b1 + hstepB, ob0); PG8_STAGE_O(PG8_SA(1, 1), a1, oa0, oa1); } \
            WAITR; PG8_WAIT_L(0); PG8_BAR; PG8_MMA(0, 0, At, B0); PG8_MMA(0, 1, At, B1); PG8_BAR; PG8_SCHED; \
            { unsigned ob0, oa0, oa1; PG8_RD(ob0, 0, 8); PG8_RD(oa0, p2, 0); PG8_RD(oa1, p2, 1); \
              PG8_LDA(At, 0, 1); PG8_SCHED; PG8_WAIT_L(8); PG8_STAGE_B(PG8_SB(0, 0), b2, ob0); PG8_STAGE_O(PG8_SA(0, 0), a2, oa0, oa1); } \
            PG8_WAIT_V(6); PG8_WAIT_L(0); PG8_BAR; PG8_MMA(1, 0, At, B0); PG8_MMA(1, 1, At, B1); PG8_BAR; PG8_SCHED; \
            { unsigned ob0, oa0, oa1; PG8_RD(ob0, 0, 8); PG8_RD(oa0, p2, 2); PG8_RD(oa1, p2, 3); \
              PG8_LDB(B0, 1, 0); PG8_LDB(B1, 1, 1); PG8_SCHED; PG8_LDA(At, 1, 0); PG8_SCHED; PG8_WAIT_L(15); PG8_STAGE_B(PG8_SB(0, 1), b2 + hstepB, ob0); PG8_STAGE_O(PG8_SA(0, 1), a2, oa0, oa1); } \
            PG8_WAIT_V(8); PG8_WAIT_L(0); PG8_BAR; PG8_MMA(0, 0, At, B0); PG8_MMA(0, 1, At, B1); PG8_BAR; PG8_SCHED; \
            { unsigned ob0, oa0, oa1; PG8_RD(ob0, 0, 8); PG8_RD(oa0, p2, 0); PG8_RD(oa1, p2, 1); \
              PG8_LDA(At, 1, 1); PG8_SCHED; PG8_WAIT_L(8); PG8_STAGE_B(PG8_SB(1, 0), b3, ob0); PG8_STAGE_O(PG8_SA(1, 0), a3, oa0, oa1); } \
            PG8_WAIT_V(6); PG8_WAIT_L(0); PG8_BAR; PG8_MMA(1, 0, At, B0); PG8_MMA(1, 1, At, B1); PG8_BAR; PG8_SCHED; \
        } while (0)
        if constexpr (Epi::NST > 0) {
            PG8_KITER(0, PG8_WAIT_V2(Epi::NST));
#pragma unroll 1
            for (int t = 2; t < nt; t += 2) PG8_KITER(t, PG8_WAIT_V(8));
        } else {
#pragma unroll 1
            for (int t = 0; t < nt; t += 2) PG8_KITER(t, PG8_WAIT_V(8));
        }
#undef PG8_KITER
#pragma unroll
        for (int a = 0; a < 2; ++a)
#pragma unroll
            for (int b = 0; b < 2; ++b)
#pragma unroll
                for (int m = 0; m < 4; ++m) asm volatile("" : "+v"(acc[a][b][m][0]), "+v"(acc[a][b][m][1]));
        if constexpr (ALIGN_EPI) { if (wr == 0) PG8_BAR; }
        {
            Unit ue = cur; asm volatile("" : "+v"(ue.pm), "+v"(ue.pn), "+v"(ue.aux), "+v"(ue.aux2));
            ue.pm = __builtin_amdgcn_readfirstlane(ue.pm); ue.pn = __builtin_amdgcn_readfirstlane(ue.pn); ue.aux = __builtin_amdgcn_readfirstlane(ue.aux); ue.aux2 = __builtin_amdgcn_readfirstlane(ue.aux2);
            const int l2_ = lane_now();
            if constexpr (Epi::HAS_PRE) E(acc, ue, wr, wc, l2_ & 15, l2_ >> 4, ldsbase + PRE_OFF + (unsigned)p3 * 1024u); else E(acc, ue, wr, wc, l2_ & 15, l2_ >> 4);
        }
        if (!has_next) break;
#pragma unroll
        for (int a = 0; a < 2; ++a)
#pragma unroll
            for (int b = 0; b < 2; ++b)
#pragma unroll
                for (int m = 0; m < 4; ++m)
#pragma unroll
                    for (int n = 0; n < 2; ++n) acc[a][b][m][n] = (f32x4){0.f, 0.f, 0.f, 0.f};
        cur = nxt; cB = nB; ++ui; p3 = n3;
        if constexpr (ALIGN_EPI) { if (wr == 1) PG8_BAR; }
    }
    PG8_WAIT_V(0);
    if constexpr (!ALIGN_EPI) { if (wr == 0) PG8_BAR; }
    PG8_BAR;
#undef PG8_FILL
#undef PG8_RD
#undef PG8_STAGE_O
#undef PG8_STAGE_B
#undef PG8_DMA1
#undef PG8_STAGE_A
#undef PG8_SA
#undef PG8_SB
#undef PG8_STAGE
#undef PG8_LDA
#undef PG8_LDB
#undef PG8_MMA
#undef PG8_WAIT_V
#undef PG8_WAIT_V2
#undef PG8_WAIT_L
#undef PG8_BAR
#undef PG8_SCHED
}

struct EpiP {
    static constexpr int SC_W = 0x7f7f7f7f, SC_X = 0x7f7f7f7f;
    static constexpr bool PERM = true, HAS_MID = false, HAS_PRE = false; static constexpr int NST = 16;
    bf16_t* O; int ldc;
    __device__ __forceinline__ void operator()(const f32x4 (&acc)[2][2][4][2], const Unit& u, int wr, int wc, int fr, int fq) const {
        const int row0 = u.pm * BM + wr * 64 + fr, col0 = u.pn * BM + wc * 32 + 8 * fq;
#pragma unroll
        for (int ai = 0; ai < 2; ++ai)
#pragma unroll
            for (int m = 0; m < 4; ++m) { bf16_t* rowp = O + (size_t)(row0 + ai * HALF + m * 16) * ldc + col0;
#pragma unroll
                for (int bj = 0; bj < 2; ++bj) { f32x4 v0 = acc[ai][bj][m][0] * (PG_F8 ? 0.0078125f : 1.f), v1 = acc[ai][bj][m][1] * (PG_F8 ? 0.0078125f : 1.f);
                    if (u.pn * BM >= GT_OFF) {
#pragma unroll
                        for (int q = 0; q < 4; ++q) { v0[q] = __builtin_amdgcn_rcpf(1.f + __expf(-v0[q])); v1[q] = __builtin_amdgcn_rcpf(1.f + __expf(-v1[q])); } }
                    u32x4 w; w.x = cvt_pk_bf16(v0[0], v0[1]); w.y = cvt_pk_bf16(v0[2], v0[3]); w.z = cvt_pk_bf16(v1[0], v1[1]); w.w = cvt_pk_bf16(v1[2], v1[3]);
                    *(u32x4*)(rowp + bj * HALF) = w; } }
    }
};
}

__device__ __forceinline__ unsigned pk2(float lo, float hi) { return (unsigned)f2bf(lo) | ((unsigned)f2bf(hi) << 16); }
__device__ __forceinline__ void transpose_item(const float* W, int N, bf16_t* WT, int ldt, LAS float* scr, int k0s, int k0d, int n0, int row0, int lane) {
#pragma unroll 8
    for (int i = 0; i < 32; ++i) { const int kk = 2 * i + (lane >> 5); scr[kk * 33 + (lane & 31)] = W[(size_t)(k0s + kk) * N + n0 + (lane & 31)]; }
    asm volatile("s_waitcnt lgkmcnt(0)" ::: "memory");
    const int c = lane & 7;
#pragma unroll
    for (int j = 0; j < 4; ++j) { const int n = (lane >> 3) + 8 * j; const LAS float* s = scr + (8 * c) * 33 + n;
        u32x4 o; o.x = pk2(s[0 * 33], s[1 * 33]); o.y = pk2(s[2 * 33], s[3 * 33]); o.z = pk2(s[4 * 33], s[5 * 33]); o.w = pk2(s[6 * 33], s[7 * 33]);
        *(u32x4*)(WT + (size_t)(row0 + n) * ldt + k0d + 8 * c) = o; }
    asm volatile("s_waitcnt lgkmcnt(0)" ::: "memory");
}
__device__ __forceinline__ void transpose_item_f8(const float* W, int N, unsigned char* WT, int ldt, LAS float* scr, int k0s, int k0d, int n0, int row0, int lane, float scale) {
#pragma unroll 8
    for (int i = 0; i < 32; ++i) { const int kk = 2 * i + (lane >> 5); scr[kk * 33 + (lane & 31)] = W[(size_t)(k0s + kk) * N + n0 + (lane & 31)] * scale; }
    asm volatile("s_waitcnt lgkmcnt(0)" ::: "memory");
    const int c = lane & 7;
#pragma unroll
    for (int j = 0; j < 4; ++j) { const int n = (lane >> 3) + 8 * j; const LAS float* s = scr + (8 * c) * 33 + n;
        const int lo = pk4_fp8(s[0 * 33], s[1 * 33], s[2 * 33], s[3 * 33]), hi = pk4_fp8(s[4 * 33], s[5 * 33], s[6 * 33], s[7 * 33]);
        *(u32x2*)(WT + (size_t)(row0 + n) * ldt + k0d + 8 * c) = (u32x2){(unsigned)lo, (unsigned)hi}; }
    asm volatile("s_waitcnt lgkmcnt(0)" ::: "memory");
}
__device__ __forceinline__ void transpose_small(const Params& P, LAS float* scr, const Ctx& c) {
    bf16_t* WTIN = (bf16_t*)(P.ws + WS_WTIN); bf16_t* WTBR = (bf16_t*)(P.ws + WS_WTBR); bf16_t* WTOUT = (bf16_t*)(P.ws + WS_WTOUT); bf16_t* WTRS = (bf16_t*)(P.ws + WS_WTRS); bf16_t* WTSHD = (bf16_t*)(P.ws + WS_WTSHD);
    constexpr int I_IN = 16 * 152, I_BR = 8 * 32, I_OUT = 16 * 32, I_R = 16 * 8, I_SD = 4 * 32, I_L = 16;
    constexpr int TOTAL = I_IN + 2 * I_BR + I_OUT + 3 * I_R + I_SD + 4 * I_L;
    bf16_t* W2T = (bf16_t*)(P.ws + WS_LORA); bf16_t* A2T = W2T + 512 * 64; bf16_t* G2T = A2T + 512 * 64;
    for (int it = c.gwave; it < TOTAL; it += c.nwaves) {
        int r = it;
        if (r < I_IN) { const int kb = r / 152, nb = r % 152;
            if (PG_F8) transpose_item_f8(P.in[5], INC, (unsigned char*)WTIN, D, scr, 64 * kb, 64 * kb, 32 * nb, 32 * nb, c.lane, 64.f);
            else transpose_item(P.in[5], INC, WTIN, D, scr, 64 * kb, 64 * kb, 32 * nb, 32 * nb, c.lane);
            continue; } r -= I_IN;
        if (r < I_BR) { const int kb = r / 32, nb = r % 32; if (MRG_F8) transpose_item_f8(P.in[21], D, (unsigned char*)WTBR, D, scr, 64 * kb, 64 * kb, 32 * nb, 32 * nb, c.lane, 64.f); else transpose_item(P.in[21], D, WTBR, D, scr, 64 * kb, 64 * kb, 32 * nb, 32 * nb, c.lane); continue; } r -= I_BR;
        if (r < I_BR) { const int kb = r / 32, nb = r % 32; if (MRG_F8) transpose_item_f8(P.in[22], D, (unsigned char*)WTBR, D, scr, 64 * kb, CW + 64 * kb, 32 * nb, 32 * nb, c.lane, 64.f); else transpose_item(P.in[22], D, WTBR, D, scr, 64 * kb, CW + 64 * kb, 32 * nb, 32 * nb, c.lane); continue; } r -= I_BR;
        if (r < I_OUT) { const int kb = r / 32, nb = r % 32; if (OUT_F8) transpose_item_f8(P.in[23], D, (unsigned char*)WTOUT, D, scr, 64 * kb, 64 * kb, 32 * nb, 32 * nb, c.lane, 64.f); else transpose_item(P.in[23], D, WTOUT, D, scr, 64 * kb, 64 * kb, 32 * nb, 32 * nb, c.lane); continue; } r -= I_OUT;
        if (r < I_R) { const int kb = r / 8, nb = r % 8; transpose_item(P.in[25], NE, WTRS, D, scr, 64 * kb, 64 * kb, 32 * nb, 32 * nb, c.lane); continue; } r -= I_R;
        if (r < I_R) { const int kb = r / 8, nb = r % 8, n0 = 32 * nb; transpose_item_f8(P.in[30], ED, P.ws + WS_WTRS + 512 * 1024, D, scr, 64 * kb, 64 * kb, n0, n0 < 128 ? n0 : 256 + (n0 - 128), c.lane, 64.f); continue; } r -= I_R;
        if (r < I_R) { const int kb = r / 8, nb = r % 8, n0 = 32 * nb; transpose_item_f8(P.in[31], ED, P.ws + WS_WTRS + 512 * 1024, D, scr, 64 * kb, 64 * kb, n0, n0 < 128 ? 128 + n0 : 384 + (n0 - 128), c.lane, 64.f); continue; } r -= I_R;
        if (r < I_SD) { const int kb = r / 32, nb = r % 32; transpose_item(P.in[32], D, WTSHD, ED, scr, 64 * kb, 64 * kb, 32 * nb, 32 * nb, c.lane); continue; } r -= I_SD;
        if (r < I_L) { transpose_item(P.in[8], CW, W2T, 64, scr, 0, 0, 32 * r, 32 * r, c.lane); continue; } r -= I_L;
        if (r < I_L) { transpose_item(P.in[10], CW, A2T, 64, scr, 0, 0, 32 * r, 32 * r, c.lane); continue; } r -= I_L;
        { const int kb = r / 16, nb = r % 16; transpose_item(P.in[11], CW, G2T, 128, scr, 64 * kb, 64 * kb, 32 * nb, 32 * nb, c.lane); }
    }
}
struct MoeItem { const float* W; unsigned char* WT; int N, ldt, k0, n0, row0; float scale; };
__device__ __forceinline__ MoeItem moe_item(const Params& P, int sup, int half) {
    unsigned char* WTGU = P.ws + WS_WTGU; unsigned char* WTDN = P.ws + WS_WTDN;
    const int e = sup / 192; int r = sup % 192; MoeItem m;
    if (r < 128) { const int up = r >> 6; r &= 63; const int kb = 2 * (r / 8) + half, n0 = 32 * (r % 8);
        m.W = (up ? P.in[28] : P.in[27]) + (size_t)e * D * ED; m.N = ED; m.WT = WTGU + (size_t)e * 512 * D; m.ldt = D; m.k0 = 64 * kb; m.n0 = n0; m.row0 = (n0 < 128 ? n0 : 256 + (n0 - 128)) + 128 * up; m.scale = 64.f; }
    else { r -= 128; const int kb = 2 * (r / 32) + half, n0 = 32 * (r % 32);
        m.W = P.in[29] + (size_t)e * ED * D; m.N = D; m.WT = WTDN + (size_t)e * D * ED; m.ldt = ED; m.k0 = 64 * kb; m.n0 = n0; m.row0 = n0; m.scale = 32.f; }
    return m;
}
__device__ __forceinline__ void moe_item_dma(const MoeItem& m, int lane, unsigned buf) {
    const unsigned voff = (unsigned)((lane >> 3) * m.N + 4 * (lane & 7)) * 4u;
    const unsigned long g_ = (unsigned long)(m.W + (size_t)m.k0 * m.N + m.n0);
    const char* gb = (const char*)(((unsigned long)(unsigned)__builtin_amdgcn_readfirstlane((int)(g_ >> 32)) << 32) | (unsigned long)(unsigned)__builtin_amdgcn_readfirstlane((int)g_));
    const unsigned step = (unsigned)__builtin_amdgcn_readfirstlane(m.N) * 32u, b0 = (unsigned)__builtin_amdgcn_readfirstlane((int)buf);
#pragma unroll
    for (int ci = 0; ci < 8; ++ci)
        asm volatile("s_mov_b32 m0, %0\n\ts_nop 0\n\tglobal_load_lds_dwordx4 %1, %2" :: "s"(b0 + (unsigned)ci * 1056u), "v"(voff), "s"(gb + (size_t)ci * step) : "memory", "m0");
}
__device__ __forceinline__ void moe_pair_out(const MoeItem& m, int lane, unsigned bufb) {
    const int c = lane & 7;
#pragma unroll
    for (int j = 0; j < 4; ++j) { const int n = (lane >> 3) + 8 * j;
        const LAS float* s = (const LAS float*)(unsigned long)(bufb + (unsigned)(c >> 2) * 8448u + (unsigned)(2 * (c & 3)) * 1056u + (unsigned)n * 4u);
        float f[16];
#pragma unroll
        for (int i = 0; i < 16; ++i) f[i] = s[(i >> 3) * 264 + (i & 7) * 32] * m.scale;
        u32x4 o; o.x = (unsigned)pk4_fp8(f[0], f[1], f[2], f[3]); o.y = (unsigned)pk4_fp8(f[4], f[5], f[6], f[7]); o.z = (unsigned)pk4_fp8(f[8], f[9], f[10], f[11]); o.w = (unsigned)pk4_fp8(f[12], f[13], f[14], f[15]);
        *(u32x4*)(m.WT + (size_t)(m.row0 + n) * m.ldt + m.k0 + 16 * c) = o; }
    asm volatile("s_waitcnt lgkmcnt(0)" ::: "memory");
}
__device__ __forceinline__ void transpose_moe(const Params& P, LAS unsigned char* lds, int wv, const Ctx& c, int sup_lo, int sup_hi) {
    static_assert(MOE1_F8, "expert weights are converted to fp8 only");
    const unsigned bufb = (unsigned)(unsigned long)lds + (unsigned)wv * 17408u;
    for (int sup = sup_lo + c.gwave; sup < sup_hi; sup += c.nwaves) {
        const MoeItem m0 = moe_item(P, sup, 0), m1 = moe_item(P, sup, 1);
        moe_item_dma(m0, c.lane, bufb); moe_item_dma(m1, c.lane, bufb + 8448u);
        asm volatile("s_waitcnt vmcnt(0)" ::: "memory");
        moe_pair_out(m0, c.lane, bufb);
    }
}

namespace pg8 {
__device__ __forceinline__ float bflo(unsigned u) { return __uint_as_float(u << 16); }
__device__ __forceinline__ float bfhi(unsigned u) { return __uint_as_float(u & 0xffff0000u); }
__device__ __forceinline__ float bfe(const u32x4& v, int e) { const unsigned w = v[e >> 1]; return (e & 1) ? bfhi(w) : bflo(w); }
__device__ __forceinline__ float fsig(float x) { return __builtin_amdgcn_rcpf(1.f + __expf(-x)); }

struct EpiMerge {
    static constexpr int SC_W = 0x7f7f7f7f, SC_X = 0x7f7f7f7f;
    static constexpr bool PERM = true, HAS_MID = true, HAS_PRE = false; static constexpr int NST = 0;
    const bf16_t* Pp; bf16_t* O;
    __device__ __forceinline__ void mid(f32x4 (&acc)[2][2][4][2], const Unit& u, int wr, int wc, int fr, int fq) const {
        const int row0 = u.pm * BM + wr * 64 + fr, col0 = u.pn * BM + wc * 32 + 8 * fq;
#pragma unroll
        for (int ai = 0; ai < 2; ++ai) {
            u32x4 x1[4][2], x2[4][2];
#pragma unroll
            for (int m = 0; m < 4; ++m) { const bf16_t* pr = Pp + (size_t)(row0 + ai * HALF + m * 16) * INC + GT_OFF + col0;
#pragma unroll
                for (int bj = 0; bj < 2; ++bj) { x1[m][bj] = *(const u32x4*)(pr + bj * HALF); x2[m][bj] = *(const u32x4*)(pr + D + bj * HALF); } }
#pragma unroll
            for (int m = 0; m < 4; ++m)
#pragma unroll
                for (int bj = 0; bj < 2; ++bj)
#pragma unroll
                    for (int e = 0; e < 8; ++e) { const float ratio = bfe(x1[m][bj], e) * __builtin_amdgcn_rcpf(bfe(x2[m][bj], e)) * (MRG_F8 ? OGM_SCALE / ORW_SCALE : 1.f); acc[ai][bj][m][e >> 2][e & 3] *= ratio; }
            asm volatile("" ::: "memory");
        }
    }
    __device__ __forceinline__ void operator()(const f32x4 (&acc)[2][2][4][2], const Unit& u, int wr, int wc, int fr, int fq) const {
        const int row0 = u.pm * BM + wr * 64 + fr, col0 = u.pn * BM + wc * 32 + 8 * fq;
#pragma unroll
        for (int ai = 0; ai < 2; ++ai) {
            u32x4 x2[4][2];
#pragma unroll
            for (int m = 0; m < 4; ++m)
#pragma unroll
                for (int bj = 0; bj < 2; ++bj) x2[m][bj] = *(const u32x4*)(Pp + (size_t)(row0 + ai * HALF + m * 16) * INC + GT_OFF + D + col0 + bj * HALF);
#pragma unroll
            for (int m = 0; m < 4; ++m) { const size_t r = (size_t)(row0 + ai * HALF + m * 16);
                if constexpr (OUT_F8) {
                    unsigned pk[2][2];
#pragma unroll
                    for (int bj = 0; bj < 2; ++bj) { float v[8];
#pragma unroll
                        for (int e = 0; e < 8; ++e) v[e] = acc[ai][bj][m][e >> 2][e & 3] * bfe(x2[m][bj], e) * (MRG_F8 ? MRG_SCALE / (OGM_SCALE * 64.f) : MRG_SCALE);
                        pk[bj][0] = (unsigned)pk4_fp8(v[0], v[1], v[2], v[3]); pk[bj][1] = (unsigned)pk4_fp8(v[4], v[5], v[6], v[7]); }
                    const auto sl = __builtin_amdgcn_permlane16_swap(pk[0][0], pk[1][0], false, false);
                    const auto sh = __builtin_amdgcn_permlane16_swap(pk[0][1], pk[1][1], false, false);
                    *(u32x4*)((unsigned char*)O + r * D + (u.pn * BM + wc * 32 + 8 * (fq & ~1) + HALF * (fq & 1))) = (u32x4){sl[0], sh[0], sl[1], sh[1]};
                } else {
#pragma unroll
                for (int bj = 0; bj < 2; ++bj) { float v[8];
#pragma unroll
                    for (int e = 0; e < 8; ++e) v[e] = acc[ai][bj][m][e >> 2][e & 3] * bfe(x2[m][bj], e) * (MRG_F8 ? 1.f / (OGM_SCALE * 64.f) : 1.f);
                    u32x4 w; w.x = cvt_pk_bf16(v[0], v[1]); w.y = cvt_pk_bf16(v[2], v[3]); w.z = cvt_pk_bf16(v[4], v[5]); w.w = cvt_pk_bf16(v[6], v[7]);
                    *(u32x4*)(O + r * D + col0 + bj * HALF) = w; } } }
            asm volatile("" ::: "memory");
        }
    }
};
struct EpiOut {
    static constexpr int SC_W = 0x7f7f7f7f, SC_X = 0x7f7f7f7f;
    static constexpr bool PERM = true, HAS_MID = false, HAS_PRE = false; static constexpr int NST = 0;
    const float* x; const float* mod; bf16_t* out;
    __device__ __forceinline__ void operator()(const f32x4 (&acc)[2][2][4][2], const Unit& u, int wr, int wc, int fr, int fq) const {
        const int row0 = u.pm * BM + wr * 64 + fr, col0 = u.pn * BM + wc * 32 + 8 * fq;
        const float* gt = mod + (size_t)((u.pm * BM) / SEQ) * 6 * D + 2 * D;
#pragma unroll
        for (int bj = 0; bj < 2; ++bj) { const int col = col0 + bj * HALF; const f32x4 g0 = *(const f32x4*)(gt + col) * (OUT_F8 ? 1.f / (MRG_SCALE * 64.f) : 1.f), g1 = *(const f32x4*)(gt + col + 4) * (OUT_F8 ? 1.f / (MRG_SCALE * 64.f) : 1.f);
#pragma unroll
            for (int ai = 0; ai < 2; ++ai)
#pragma unroll
                for (int m = 0; m < 4; ++m) { const size_t o = (size_t)(row0 + ai * HALF + m * 16) * D + col; const f32x4 x0 = *(const f32x4*)(x + o), x1 = *(const f32x4*)(x + o + 4);
                    const f32x4 v0 = x0 + g0 * acc[ai][bj][m][0], v1 = x1 + g1 * acc[ai][bj][m][1];
                    u32x4 w; w.x = cvt_pk_bf16(v0[0], v0[1]); w.y = cvt_pk_bf16(v0[2], v0[3]); w.z = cvt_pk_bf16(v1[0], v1[1]); w.w = cvt_pk_bf16(v1[2], v1[3]);
                    *(u32x4*)(out + o) = w; }
            asm volatile("" ::: "memory"); }
    }
};
struct EpiRouter {
    static constexpr int SC_W = 0x7f7f7f7f, SC_X = 0x7f7f7f7f;
    static constexpr bool PERM = true, HAS_MID = false, HAS_PRE = false; static constexpr int NST = 0;
    float* LG;
    __device__ __forceinline__ void operator()(const f32x4 (&acc)[2][2][4][2], const Unit& u, int wr, int wc, int fr, int fq) const {
        const int row0 = u.pm * BM + wr * 64 + fr;
#pragma unroll
        for (int ai = 0; ai < 2; ++ai)
#pragma unroll
            for (int m = 0; m < 4; ++m) { float* rp = LG + (size_t)(row0 + ai * HALF + m * 16) * NE + wc * 32 + 8 * fq;
#pragma unroll
                for (int bj = 0; bj < 2; ++bj) { *(f32x4*)(rp + bj * HALF) = acc[ai][bj][m][0]; *(f32x4*)(rp + bj * HALF + 4) = acc[ai][bj][m][1]; } }
    }
};
struct EpiShared {
    static constexpr int SC_W = 0x7f7f7f7f, SC_X = 0x7f7f7f7f;
    static constexpr bool PERM = true, HAS_MID = false, HAS_PRE = false; static constexpr int NST = 0;
    bf16_t* ASH;
    __device__ __forceinline__ void operator()(const f32x4 (&acc)[2][2][4][2], const Unit& u, int wr, int wc, int fr, int fq) const {
        const int row0 = u.pm * BM + wr * 64 + fr, j0 = 128 * u.pn + wc * 32 + 8 * fq;
#pragma unroll
        for (int ai = 0; ai < 2; ++ai)
#pragma unroll
            for (int m = 0; m < 4; ++m) { float v[8];
#pragma unroll
                for (int e = 0; e < 8; ++e) { const float g = acc[ai][0][m][e >> 2][e & 3] * 0.0078125f, up = acc[ai][1][m][e >> 2][e & 3] * 0.0078125f; v[e] = g * fsig(g) * up; }
                u32x4 w; w.x = cvt_pk_bf16(v[0], v[1]); w.y = cvt_pk_bf16(v[2], v[3]); w.z = cvt_pk_bf16(v[4], v[5]); w.w = cvt_pk_bf16(v[6], v[7]);
                *(u32x4*)(ASH + (size_t)(row0 + ai * HALF + m * 16) * ED + j0) = w; }
    }
};

struct MoeSched1 {
    const int* row_tok; const int* tile_e; int nunits, G, c; const char* W;
    __device__ __forceinline__ bool next(int i, Unit& u) const { const int L = i * G + c; if (L >= nunits) return false; u.pm = L >> 1; u.pn = L & 1; u.aux = sload1(tile_e + u.pm); u.aux2 = 0; return true; }
    __device__ __forceinline__ unsigned a_off(const Unit& u, int r) const { return (unsigned)row_tok[u.pm * BM + r] * (unsigned)(D * (MOE1_F8 ? 1 : 2)); }
    __device__ __forceinline__ const char* b_ptr(const Unit& u) const { return W + ((size_t)u.aux * 512 + (size_t)u.pn * 256) * (D * (MOE1_F8 ? 1 : 2)); }
};
struct EpiMoe1 {
    static constexpr bool PERM = true, HAS_MID = false, HAS_PRE = false; static constexpr int NST = 0; static constexpr int SC_W = 0x7f7f7f7f, SC_X = 0x7f7f7f7f;
    bf16_t* ACT;
    __device__ __forceinline__ void operator()(const f32x4 (&acc)[2][2][4][2], const Unit& u, int wr, int wc, int fr, int fq) const {
        const int row0 = u.pm * BM + wr * 64 + fr, j0 = 128 * u.pn + wc * 32 + 8 * fq;
#pragma unroll
        for (int ai = 0; ai < 2; ++ai)
#pragma unroll
            for (int m = 0; m < 4; ++m) { float v[8];
#pragma unroll
                for (int e = 0; e < 8; ++e) { const float g = acc[ai][0][m][e >> 2][e & 3] * (MOE1_F8 ? 0.0078125f : 1.f), up = acc[ai][1][m][e >> 2][e & 3] * ((MOE1_F8 ? 0.0078125f : 1.f) * 16.f); v[e] = g * fsig(g) * up; }
                const int lo = pk4_fp8(v[0], v[1], v[2], v[3]), hi = pk4_fp8(v[4], v[5], v[6], v[7]);
                *(u32x2*)((unsigned char*)ACT + (size_t)(row0 + ai * HALF + m * 16) * ED + j0) = (u32x2){(unsigned)lo, (unsigned)hi}; }
    }
};
struct MoeSched2 {
    const int* tile_e; int nunits, G, c; const char* W;
    __device__ __forceinline__ bool next(int i, Unit& u) const { const int L = i * G + c; if (L >= nunits) return false; u.pm = L >> 2; u.pn = L & 3; int cb_, va_; sload3(tile_e + u.pm, tile_e + 2048 + u.pm, tile_e + 4096 + u.pm, u.aux, cb_, va_); u.aux2 = cb_ | (va_ << 20); return true; }
    __device__ __forceinline__ unsigned a_off(const Unit& u, int r) const { return (unsigned)(u.pm * BM + r) * (unsigned)ED; }
    __device__ __forceinline__ const char* b_ptr(const Unit& u) const { return W + ((size_t)u.aux * D + (size_t)u.pn * 256) * ED; }
};
struct EpiMoe2 {
    static constexpr bool PERM = true, HAS_MID = false, HAS_PRE = true; static constexpr int NST = 9;        static constexpr int SC_W = 0x7f7f7f7f, SC_X = 0x7f7f7f7f;
    bf16_t* YS; const float* row_w; unsigned char* dump;
    __device__ __forceinline__ void pre(int pm, unsigned ldsaddr, int wid) const {
        { const unsigned la = ldsaddr + (unsigned)(wid & 3) * 256u, vo = (unsigned)lane_now() * 4u; const float* gp = row_w + pm * BM + (wid & 3) * 64;
            const unsigned long g_ = (unsigned long)gp; const float* gs = (const float*)(((unsigned long)(unsigned)__builtin_amdgcn_readfirstlane((int)(g_ >> 32)) << 32) | (unsigned long)(unsigned)__builtin_amdgcn_readfirstlane((int)g_));
            asm volatile("s_mov_b32 m0, %0\n\ts_nop 0\n\tglobal_load_lds_dword %1, %2" :: "s"(la), "v"(vo), "s"(gs) : "memory", "m0"); }
    }
    __device__ __forceinline__ void operator()(const f32x4 (&acc)[2][2][4][2], const Unit& u, int wr, int wc, int fr, int fq, unsigned ldsaddr) const {
        const int cbase = u.aux2 & 0xFFFFF, valid = u.aux2 >> 20;
        const LAS float* rwp = (const LAS float*)(unsigned long)(ldsaddr + (unsigned)(wr * 64 + fr) * 4u); float w8[2][4];
#pragma unroll
        for (int ai = 0; ai < 2; ++ai)
#pragma unroll
            for (int m = 0; m < 4; ++m) w8[ai][m] = rwp[ai * HALF + m * 16];
        const int col0 = u.pn * BM + wc * 32 + 8 * (fq & ~1) + HALF * (fq & 1);
#pragma unroll
        for (int ai = 0; ai < 2; ++ai)
#pragma unroll
            for (int m = 0; m < 4; ++m) { const int r = ai * HALF + wr * 64 + m * 16 + fr; const float w_ = w8[ai][m] * (YS_SCALE * 0.001953125f);
                const f32x4 p0 = acc[ai][0][m][0] * w_, p1 = acc[ai][0][m][1] * w_, q0 = acc[ai][1][m][0] * w_, q1 = acc[ai][1][m][1] * w_;
                const auto sl = __builtin_amdgcn_permlane16_swap((unsigned)pk4_fp8(p0[0], p0[1], p0[2], p0[3]), (unsigned)pk4_fp8(q0[0], q0[1], q0[2], q0[3]), false, false);
                const auto sh = __builtin_amdgcn_permlane16_swap((unsigned)pk4_fp8(p1[0], p1[1], p1[2], p1[3]), (unsigned)pk4_fp8(q1[0], q1[1], q1[2], q1[3]), false, false);
                unsigned char* dst = (r < valid) ? (unsigned char*)YS + (size_t)(cbase + r) * D + col0 : dump + (col0 & 1023);
                *(u32x4*)dst = (u32x4){sl[0], sh[0], sl[1], sh[1]}; }
    }
};
struct EpiYsh {
    static constexpr int SC_W = 0x7f7f7f7f, SC_X = 0x7f7f7f7f;
    static constexpr bool PERM = true, HAS_MID = false, HAS_PRE = false; static constexpr int NST = 0;
    bf16_t* O;
    __device__ __forceinline__ void operator()(const f32x4 (&acc)[2][2][4][2], const Unit& u, int wr, int wc, int fr, int fq) const {
        const int row0 = u.pm * BM + wr * 64 + fr, col0 = u.pn * BM + wc * 32 + 8 * fq;
#pragma unroll
        for (int ai = 0; ai < 2; ++ai)
#pragma unroll
            for (int m = 0; m < 4; ++m) { bf16_t* rowp = O + (size_t)(row0 + ai * HALF + m * 16) * D + col0;
#pragma unroll
                for (int bj = 0; bj < 2; ++bj) { const f32x4 v0 = acc[ai][bj][m][0], v1 = acc[ai][bj][m][1];
                    u32x4 w; w.x = cvt_pk_bf16(v0[0], v0[1]); w.y = cvt_pk_bf16(v0[2], v0[3]); w.z = cvt_pk_bf16(v1[0], v1[1]); w.w = cvt_pk_bf16(v1[2], v1[3]);
                    *(u32x4*)(rowp + bj * HALF) = w; } }
    }
};
}

__device__ __forceinline__ void f_topk(const Params& P, int* lcnt, const int tid) {
    const float* LG = (const float*)(P.ws + WS_G); const float* rb = P.in[26];
    int* tok_e = (int*)(P.ws + WS_TOKE); float* tok_w = (float*)(P.ws + WS_TOKW); int* tok_lp = (int*)(P.ws + WS_TOKLP); int* blk_cnt = (int*)(P.ws + WS_BLKCNT);
    const int TPB = NTOK / gridDim.x, lane = tid & 63, wave = tid >> 6;
    for (int i = tid; i < NE; i += NT) lcnt[i] = 0;
    __syncthreads();
    float rbv[4], nx[4];
#pragma unroll
    for (int j = 0; j < 4; ++j) { rbv[j] = rb[lane + 64 * j]; nx[j] = LG[(size_t)(blockIdx.x * TPB + wave) * NE + lane + 64 * j]; }
    for (int tt = wave; tt < TPB; tt += NT / 64) {
        const int m = blockIdx.x * TPB + tt;
        float lgv[4];
#pragma unroll
        for (int j = 0; j < 4; ++j) lgv[j] = nx[j];
        if (tt + NT / 64 < TPB) {
#pragma unroll
            for (int j = 0; j < 4; ++j) nx[j] = LG[(size_t)(m + NT / 64) * NE + lane + 64 * j]; }
        float sc[4]; unsigned key[4];
#pragma unroll
        for (int j = 0; j < 4; ++j) { const int e = lane + 64 * j; sc[j] = sigmoidf_(lgv[j]); key[j] = (__float_as_uint(sc[j] + rbv[j] + 1.0f) & 0xFFFFFF00u) | (unsigned)(255 - e); }
        float wsum = 0.f; float myw = 0.f; int mye = 0;
#define DPP_MAXU(x, ctrl) x = max(x, (unsigned)__builtin_amdgcn_update_dpp(0, (int)(x), ctrl, 0xf, 0xf, true))
        for (int r = 0; r < TOPK; ++r) {
            unsigned k = max(max(key[0], key[1]), max(key[2], key[3]));
            DPP_MAXU(k, 0xB1); DPP_MAXU(k, 0x4E); DPP_MAXU(k, 0x141); DPP_MAXU(k, 0x140);
            { auto rr = __builtin_amdgcn_permlane16_swap(k, k, false, false); k = max(rr[0], rr[1]); }
            { auto rr = __builtin_amdgcn_permlane32_swap(k, k, false, false); k = max(rr[0], rr[1]); }
            const int idx = 255 - (int)(__builtin_amdgcn_readfirstlane(k) & 255u);
            const int owner = idx & 63, jsel = idx >> 6;
            const float sj = (jsel == 0) ? sc[0] : (jsel == 1) ? sc[1] : (jsel == 2) ? sc[2] : sc[3];
            const float s = __uint_as_float(__builtin_amdgcn_readlane(__float_as_uint(sj), owner));
#pragma unroll
            for (int j = 0; j < 4; ++j) if (lane == owner && j == jsel) key[j] = 0u;
            wsum += s;
            if (lane == r) { myw = s; mye = idx; }
        }
#undef DPP_MAXU
        if (lane < TOPK) {
            const int lp = __hip_atomic_fetch_add(&lcnt[mye], 1, __ATOMIC_RELAXED, __HIP_MEMORY_SCOPE_WORKGROUP);
            tok_e[m * TOPK + lane] = mye; tok_w[m * TOPK + lane] = myw / wsum * 2.5f; tok_lp[m * TOPK + lane] = lp;
        }
    }
    __syncthreads();
    for (int i = tid; i < NE; i += NT) blk_cnt[blockIdx.x * NE + i] = lcnt[i];
    __syncthreads();
}
__device__ __forceinline__ void f_route2(const Params& P, int* sm, const int tid) {
    const int* tok_e = (const int*)(P.ws + WS_TOKE); const float* tok_w = (const float*)(P.ws + WS_TOKW); const int* tok_lp = (const int*)(P.ws + WS_TOKLP); const int* blk_cnt = (const int*)(P.ws + WS_BLKCNT);
    int* tok_dest = (int*)(P.ws + WS_TOKDEST); int* row_tok = (int*)(P.ws + WS_ROWTOK); float* row_w = (float*)(P.ws + WS_ROWW);
    int* tile_e = (int*)(P.ws + WS_TILE); int* tile_cbase = tile_e + 2048; int* tile_valid = tile_e + 4096; int* ntiles = tile_e + 6144;
    int* s_tot = sm; int* s_base = sm + 256; int* s_ps = sm + 512; int* s_cs = sm + 768; int* s_misc = sm + 1024;
    const int G = gridDim.x, TPB = NTOK / G, lane = tid & 63;
    {
        typedef int i32x4_ __attribute__((ext_vector_type(4)));
        const int wv = tid >> 6; i32x4_ tot = {0, 0, 0, 0}, base = {0, 0, 0, 0};
#pragma unroll 8
        for (int b2 = wv; b2 < G; b2 += NT / 64) { const i32x4_ v = *(const i32x4_*)(blk_cnt + b2 * NE + 4 * lane); tot += v; if (b2 < (int)blockIdx.x) base += v; }
        int* part = sm - 16384;
#pragma unroll
        for (int j = 0; j < 4; ++j) { part[wv * 512 + 4 * lane + j] = tot[j]; part[wv * 512 + 256 + 4 * lane + j] = base[j]; }
        __syncthreads();
        { const int e = tid & 255, which = tid >> 8; int s = 0;
#pragma unroll
          for (int w2 = 0; w2 < NT / 64; ++w2) s += part[w2 * 512 + which * 256 + e];
          if (which == 0) s_tot[e] = s; else s_base[e] = s; }
    }
    __syncthreads();
    if (tid < 64) {
        int t[4], sp = 0, scs = 0;
#pragma unroll
        for (int j = 0; j < 4; ++j) { t[j] = s_tot[4 * lane + j]; sp += (t[j] + 255) & ~255; scs += t[j]; }
        int ip = sp, ic = scs;
#pragma unroll
        for (int o = 1; o < 64; o <<= 1) { const int a = __shfl_up(ip, o), b = __shfl_up(ic, o); if (lane >= o) { ip += a; ic += b; } }
        int ps = ip - sp, cs = ic - scs;
#pragma unroll
        for (int j = 0; j < 4; ++j) { s_ps[4 * lane + j] = ps; s_cs[4 * lane + j] = cs; ps += (t[j] + 255) & ~255; cs += t[j]; }
        if (lane == 63) s_misc[0] = ip;
    }
    __syncthreads();
    for (int pi = tid; pi < TPB * TOPK; pi += NT) {
        const int pair = blockIdx.x * TPB * TOPK + pi; const int e = tok_e[pair]; const int li = s_base[e] + tok_lp[pair];
        const int prow = s_ps[e] + li;
        tok_dest[pair] = s_cs[e] + li; row_tok[prow] = pair / TOPK; row_w[prow] = tok_w[pair];
    }
    for (int e = blockIdx.x; e < NE; e += G) {
        const int ps = s_ps[e], tot = s_tot[e], pad = (tot + 255) & ~255;
        for (int d = ps + tot + tid; d < ps + pad; d += NT) { row_tok[d] = 0; row_w[d] = 0.f; }
        for (int ti = ps / 256 + tid; ti < (ps + pad) / 256; ti += NT) { const int off = ti * 256 - ps; tile_e[ti] = e; tile_cbase[ti] = s_cs[e] + off; tile_valid[ti] = (tot - off) < 256 ? (tot - off) : 256; }
    }
    if (blockIdx.x == 0 && tid == 0) ntiles[0] = s_misc[0] / 256;
    __syncthreads();
}
__device__ __forceinline__ void f_final(const Params& P, const Ctx& c) {
    typedef float f32x2 __attribute__((ext_vector_type(2)));
    const unsigned char* YS = (const unsigned char*)(P.ws + WS_YS); const bf16_t* YSH = (const bf16_t*)(P.ws + WS_YSH); const int* tok_dest = (const int*)(P.ws + WS_TOKDEST);
    const float* mod = (const float*)(P.ws + WS_MOD); const float* g = P.in[33]; float* X = P.out;
    for (int m = c.gwave; m < NTOK; m += c.nwaves) {
        float tot[16];
#pragma unroll
        for (int i = 0; i < 16; ++i) tot[i] = 0.f;
        int dst[TOPK];
#pragma unroll
        for (int s = 0; s < TOPK; ++s) dst[s] = tok_dest[m * TOPK + s];
#pragma unroll
        for (int s = 0; s < TOPK; ++s) {
            const unsigned char* rp = YS + (size_t)dst[s] * D + 8 * c.lane;
#pragma unroll
            for (int j = 0; j < 2; ++j) { const u32x2 v = *(const u32x2*)(rp + 512 * j);
                const f32x2 a0 = __builtin_amdgcn_cvt_pk_f32_fp8((int)v[0], false), a1 = __builtin_amdgcn_cvt_pk_f32_fp8((int)v[0], true), a2 = __builtin_amdgcn_cvt_pk_f32_fp8((int)v[1], false), a3 = __builtin_amdgcn_cvt_pk_f32_fp8((int)v[1], true);
                tot[8 * j] += a0[0]; tot[8 * j + 1] += a0[1]; tot[8 * j + 2] += a1[0]; tot[8 * j + 3] += a1[1]; tot[8 * j + 4] += a2[0]; tot[8 * j + 5] += a2[1]; tot[8 * j + 6] += a3[0]; tot[8 * j + 7] += a3[1]; }
        }
        { const bf16_t* rp = YSH + (size_t)m * D + 8 * c.lane;
#pragma unroll
          for (int j = 0; j < 2; ++j) { const u32x4 v = *(const u32x4*)(rp + 512 * j);
#pragma unroll
              for (int e = 0; e < 8; ++e) tot[8 * j + e] = tot[8 * j + e] * (1.f / YS_SCALE) + pg8::bfe(v, e); } }
        const float* gt = mod + (size_t)(m / SEQ) * 6 * D + 5 * D; float* xr = X + (size_t)m * D; const bf16_t* x1r = (const bf16_t*)(P.ws + WS_X1) + (size_t)m * D; float ss = 0.f;
#pragma unroll
        for (int j = 0; j < 2; ++j)
#pragma unroll
            for (int hq = 0; hq < 2; ++hq) { const int col = 8 * c.lane + 512 * j + 4 * hq; const u32x2 xb_ = *(const u32x2*)(x1r + col); const f32x4 xv = (f32x4){pg8::bflo(xb_[0]), pg8::bfhi(xb_[0]), pg8::bflo(xb_[1]), pg8::bfhi(xb_[1])}, gv = *(const f32x4*)(gt + col);
#pragma unroll
                for (int q = 0; q < 4; ++q) { const float v = xv[q] + gv[q] * tot[8 * j + 4 * hq + q]; tot[8 * j + 4 * hq + q] = v; ss += v * v; } }
        ss = wave_sum(ss);
        const float rstd = rsqrtf(ss * (1.f / D) + 1e-6f);
#pragma unroll
        for (int j = 0; j < 2; ++j)
#pragma unroll
            for (int hq = 0; hq < 2; ++hq) { const int col = 8 * c.lane + 512 * j + 4 * hq; const f32x4 fg = *(const f32x4*)(g + col); f32x4 o;
#pragma unroll
                for (int q = 0; q < 4; ++q) o[q] = tot[8 * j + 4 * hq + q] * rstd * fg[q];
                *(f32x4*)(xr + col) = o; }
    }
}

#define XB_TMO      128
#define XB_XCNT(j)  (256  + 64 * (j))
#define XB_XSUB(j)  (1280 + 64 * (j))
#define XB_XGEN(j)  (2304 + 64 * (j))
#define XB_TOP      3328
#define XB_TOPGEN   3392
#define XCD_BAR_WORDS 3456
#define XB_SPIN_CAP (1u << 22)
__device__ __forceinline__ unsigned xb_ld(unsigned* p)              { return __hip_atomic_load(p, __ATOMIC_RELAXED, __HIP_MEMORY_SCOPE_AGENT); }
__device__ __forceinline__ unsigned xb_add(unsigned* p, unsigned v) { return __hip_atomic_fetch_add(p, v, __ATOMIC_RELAXED, __HIP_MEMORY_SCOPE_AGENT); }
__device__ __forceinline__ unsigned xb_xcc_id() { return (unsigned)__builtin_amdgcn_s_getreg((3 << 11) | 20) & 0xFu; }
#define XB_SPIN(cond, bar) do { unsigned _sp = 0; while (cond) { __builtin_amdgcn_s_sleep(1); \
    if ((++_sp & 255u) == 0u) { if (xb_ld(&(bar)[XB_TMO])) break; if (_sp > XB_SPIN_CAP) { atomicAdd(&(bar)[XB_TMO], 1u); break; } } } } while (0)
struct XcdBarrier { unsigned* bar; unsigned x; volatile LAS unsigned* st; };
__device__ __forceinline__ XcdBarrier xcd_barrier_post(unsigned* bar, volatile LAS unsigned* st, int tid) {
    XcdBarrier b; b.bar = bar; b.x = xb_xcc_id(); b.st = st;
    if (tid == 0) (void)xb_add(&bar[XB_XCNT(b.x)], 1u);
    return b;
}
__device__ __forceinline__ void xcd_barrier_complete(unsigned* bar, unsigned x, unsigned& nloc, unsigned& nx) {
    const unsigned G = gridDim.x * gridDim.y * gridDim.z;
    unsigned sum, cnt, mine, sp = 0u;
    for (;;) {
        sum = 0u; cnt = 0u; mine = 0u;
#pragma unroll
        for (unsigned j = 0; j < 16; ++j) { const unsigned c = xb_ld(&bar[XB_XCNT(j)]); sum += c; cnt += (c > 0u) ? 1u : 0u; mine = (j == x) ? c : mine; }
        if (sum == G) break;
        __builtin_amdgcn_s_sleep(1);
        if ((++sp & 255u) == 0u) { if (xb_ld(&bar[XB_TMO])) break; if (sp > XB_SPIN_CAP) { atomicAdd(&bar[XB_TMO], 1u); break; } }
    }
    nloc = mine > 0u ? mine : 1u; nx = cnt > 0u ? cnt : 1u;
}
__device__ __forceinline__ void xcd_barrier(const XcdBarrier& b, int tid) {
    asm volatile("s_waitcnt vmcnt(0)" ::: "memory");
    __syncthreads();
    if (tid == 0) {
        unsigned* bar = b.bar;
        __builtin_amdgcn_s_waitcnt(0);
        unsigned nloc = b.st[0], nx = b.st[1];
        if (nloc == 0u) { xcd_barrier_complete(bar, b.x, nloc, nx); b.st[0] = nloc; b.st[1] = nx; }
        const unsigned old = xb_add(&bar[XB_XSUB(b.x)], 1u);
        const unsigned gen = old / nloc;
        if (old + 1u == (gen + 1u) * nloc) {
            __builtin_amdgcn_fence(__ATOMIC_RELEASE, "agent");
            asm volatile("s_waitcnt vmcnt(0)" ::: "memory");
            const unsigned og = xb_add(&bar[XB_TOP], 1u);
            const unsigned tg = og / nx;
            if (og + 1u == (tg + 1u) * nx) xb_add(&bar[XB_TOPGEN], 1u);
            else XB_SPIN(xb_ld(&bar[XB_TOPGEN]) == tg, bar);
            __builtin_amdgcn_fence(__ATOMIC_ACQUIRE, "agent");
            xb_add(&bar[XB_XGEN(b.x)], 1u);
            asm volatile("s_waitcnt vmcnt(0)" ::: "memory");
        } else {
            XB_SPIN(xb_ld(&bar[XB_XGEN(b.x)]) == gen, bar);
            __builtin_amdgcn_fence(__ATOMIC_ACQUIRE, "agent");
            asm volatile("s_waitcnt vmcnt(0)" ::: "memory");
        }
    }
    __syncthreads();
}

#define DPP_ADD(x, ctrl) x += __uint_as_float(__builtin_amdgcn_update_dpp(0, __float_as_uint(x), ctrl, 0xf, 0xf, true))
__device__ __forceinline__ float red32(float x) {
    DPP_ADD(x, 0xB1); DPP_ADD(x, 0x4E); DPP_ADD(x, 0x141); DPP_ADD(x, 0x140);
    auto rr = __builtin_amdgcn_permlane16_swap(__float_as_uint(x), __float_as_uint(x), false, false);
    return __uint_as_float(rr[0]) + __uint_as_float(rr[1]);
}
__device__ __forceinline__ float fma_s(float a, float b, float c) { float r; asm("v_fma_f32 %0, %1, %2, %3" : "=v"(r) : "v"(a), "v"(b), "v"(c)); return r; }
__device__ __forceinline__ float mul_s(float a, float b) { float r; asm("v_mul_f32_e32 %0, %1, %2" : "=v"(r) : "v"(a), "v"(b)); return r; }
__device__ __forceinline__ float add_s(float a, float b) { float r; asm("v_add_f32_e32 %0, %1, %2" : "=v"(r) : "v"(a), "v"(b)); return r; }
__device__ __forceinline__ void f_scan(const Params& P, LAS unsigned char* lds, int tid) {
    constexpr int NCHK = SEQ / 16, SLOT = 16384, RD = 8, AHEAD = 7, PPL = 4;
    static_assert(RD * SLOT <= LDS_BYTES, "scan ring");
    const int lane = tid & 63, w = __builtin_amdgcn_readfirstlane(tid >> 6), c16 = lane & 15, g = lane >> 4;
    const int bh = blockIdx.x;
    if (bh >= NB * 8) return;
    const int b = bh >> 3, h = bh & 7;
    const unsigned char* ops = ops_ptr(P, bh);
    const bf16_t* SVb = (const bf16_t*)(P.ws + WS_SCANV) + (size_t)b * SEQ * CW + h * 64;
    if (w >= 4) {
        const int hw = w - 4;
        const unsigned lo_op = (unsigned)lane * 16u, lo_v = (unsigned)((lane >> 3) * CW + (lane & 7) * 8) * 2u;
#define SC_ISSUE(ch_) do { unsigned cc_ = (unsigned)(ch_); asm volatile("" : "+s"(cc_)); const unsigned so_ = (cc_ & (RD - 1)) * SLOT; \
            _Pragma("unroll") for (int n_ = 0; n_ < PPL; ++n_) { const int p_ = hw * PPL + n_; \
                if (p_ < 13) __builtin_amdgcn_global_load_lds((const unsigned*)(ops + (size_t)cc_ * OPB + p_ * 1024 + lo_op), (LAS unsigned*)(lds + so_ + p_ * 1024), 16, 0, 0); \
                else if (p_ < 15) __builtin_amdgcn_global_load_lds((const unsigned*)((const char*)(SVb + (size_t)(cc_ * 16 + (p_ - 13) * 8) * CW) + lo_v), (LAS unsigned*)(lds + so_ + 13312 + (p_ - 13) * 1024), 16, 0, 0); \
                else __builtin_amdgcn_global_load_lds((const unsigned*)(ops + (size_t)cc_ * OPB + lo_op), (LAS unsigned*)(lds + so_ + 15360), 16, 0, 0); } } while (0)
        for (int c0 = 0; c0 < AHEAD; ++c0) SC_ISSUE(c0);
        for (int ch = 0; ch < NCHK; ++ch) {
            if (ch + AHEAD - 1 < NCHK) asm volatile("s_waitcnt vmcnt(20)" ::: "memory");
            else asm volatile("s_waitcnt vmcnt(0)" ::: "memory");
            __builtin_amdgcn_s_barrier();
            if (ch + AHEAD < NCHK) SC_ISSUE(ch + AHEAD);
        }
#undef SC_ISSUE
    } else {
        const int rho0 = 16 * w;
        bf16_t* Y = (bf16_t*)(P.ws + WS_Y) + (size_t)b * SEQ * CW + h * 64 + rho0 + c16 + (size_t)(4 * g) * CW;
        f32x4 D0 = (f32x4){0.f, 0.f, 0.f, 0.f}, D1 = D0, D2 = D0, D3 = D0;
        u32x4 gf[8], rf[2]; u32x2 hf[4], mf; bf16_t vv[4];
#define SC_RD(ch_, GF, RF, HF, MF, VV) do { const LAS unsigned char* sl_ = lds + ((ch_) & (RD - 1)) * SLOT; \
            _Pragma("unroll") for (int i_ = 0; i_ < 8; ++i_) GF[i_] = *(const LAS u32x4*)(sl_ + i_ * 1024 + lane * 16); \
            RF[0] = *(const LAS u32x4*)(sl_ + 8192 + lane * 16); RF[1] = *(const LAS u32x4*)(sl_ + 9216 + lane * 16); \
            _Pragma("unroll") for (int i_ = 0; i_ < 4; ++i_) HF[i_] = *(const LAS u32x2*)(sl_ + 10240 + i_ * 512 + lane * 8); \
            MF = *(const LAS u32x2*)(sl_ + 12288 + lane * 8); \
            _Pragma("unroll") for (int e_ = 0; e_ < 4; ++e_) VV[e_] = *(const LAS bf16_t*)(sl_ + 13312 + (4 * g + e_) * 128 + (rho0 + c16) * 2); } while (0)
        for (int ch = 0; ch < NCHK; ++ch) {
            __builtin_amdgcn_s_barrier();
            asm volatile("" ::: "memory");
            if (ch == 0) SC_RD(0, gf, rf, hf, mf, vv);
            u32x4 ngf[8], nrf[2]; u32x2 nhf[4], nmf; bf16_t nvv[4];
            { const int chn = (ch + 1 < NCHK) ? ch + 1 : ch; SC_RD(chn, ngf, nrf, nhf, nmf, nvv); }
            __builtin_amdgcn_sched_barrier(0);
            u32x4 bs0, bs1, bv;
            bs0.x = pg8::cvt_pk_bf16(D0[0], D0[1]); bs0.y = pg8::cvt_pk_bf16(D0[2], D0[3]); bs0.z = pg8::cvt_pk_bf16(D1[0], D1[1]); bs0.w = pg8::cvt_pk_bf16(D1[2], D1[3]);
            bs1.x = pg8::cvt_pk_bf16(D2[0], D2[1]); bs1.y = pg8::cvt_pk_bf16(D2[2], D2[3]); bs1.z = pg8::cvt_pk_bf16(D3[0], D3[1]); bs1.w = pg8::cvt_pk_bf16(D3[2], D3[3]);
            bv.x = (unsigned)vv[0] | ((unsigned)vv[1] << 16); bv.y = (unsigned)vv[2] | ((unsigned)vv[3] << 16); bv.z = 0u; bv.w = 0u;
            const bf16x8 B0 = __builtin_bit_cast(bf16x8, bs0), B1 = __builtin_bit_cast(bf16x8, bs1), BV = __builtin_bit_cast(bf16x8, bv);
            const f32x4 z4 = (f32x4){0.f, 0.f, 0.f, 0.f};
#define SC_TILE(mt_) ({ f32x4 n_ = __builtin_amdgcn_mfma_f32_16x16x32_bf16(__builtin_bit_cast(bf16x8, gf[2 * (mt_)]), B0, z4, 0, 0, 0); \
                n_ = __builtin_amdgcn_mfma_f32_16x16x32_bf16(__builtin_bit_cast(bf16x8, gf[2 * (mt_) + 1]), B1, n_, 0, 0, 0); \
                const u32x4 h_ = (u32x4){hf[mt_][0], hf[mt_][1], 0u, 0u}; \
                __builtin_amdgcn_mfma_f32_16x16x32_bf16(__builtin_bit_cast(bf16x8, h_), BV, n_, 0, 0, 0); })
            const f32x4 n0 = SC_TILE(0), n1 = SC_TILE(1), n2 = SC_TILE(2), n3 = SC_TILE(3);
            f32x4 yt = __builtin_amdgcn_mfma_f32_16x16x32_bf16(__builtin_bit_cast(bf16x8, rf[0]), B0, z4, 0, 0, 0);
            yt = __builtin_amdgcn_mfma_f32_16x16x32_bf16(__builtin_bit_cast(bf16x8, rf[1]), B1, yt, 0, 0, 0);
            { const u32x4 m_ = (u32x4){mf[0], mf[1], 0u, 0u}; yt = __builtin_amdgcn_mfma_f32_16x16x32_bf16(__builtin_bit_cast(bf16x8, m_), BV, yt, 0, 0, 0); }
            D0 = n0; D1 = n1; D2 = n2; D3 = n3;
#pragma unroll
            for (int r_ = 0; r_ < 4; ++r_) Y[(size_t)(ch * 16 + r_) * CW] = f2bf(yt[r_]);
#pragma unroll
            for (int i_ = 0; i_ < 8; ++i_) gf[i_] = ngf[i_];
            rf[0] = nrf[0]; rf[1] = nrf[1];
#pragma unroll
            for (int i_ = 0; i_ < 4; ++i_) { hf[i_] = nhf[i_]; vv[i_] = nvv[i_]; }
            mf = nmf;
            asm volatile("s_waitcnt lgkmcnt(0)" ::: "memory");
#undef SC_TILE
        }
#undef SC_RD
    }
}

__device__ __forceinline__ void f_mod(const Params& P, LAS unsigned char* lds, int tid) {
    const float* cc = P.in[1]; const float* w = P.in[2]; const float* bias = P.in[3];
    float* mod = (float*)(P.ws + WS_MOD);
    LAS float* sc = (LAS float*)lds;
    LAS float* red = (LAS float*)(lds + 32768);
    const int lane = tid & 63, wv = __builtin_amdgcn_readfirstlane(tid >> 6);
    for (int item = blockIdx.x; item < 96; item += gridDim.x) {
        for (int i = tid; i < NB * D; i += NT) sc[i] = siluf_(cc[i]);
        __syncthreads();
        const int col = item * 64 + lane;
        float acc[NB];
#pragma unroll
        for (int i = 0; i < NB; ++i) acc[i] = 0.f;
#pragma unroll 16
        for (int k = wv * 128; k < wv * 128 + 128; ++k) {
            const float x = w[(size_t)k * 6 * D + col];
#pragma unroll
            for (int i = 0; i < NB; ++i) acc[i] += sc[i * D + k] * x;
        }
#pragma unroll
        for (int i = 0; i < NB; ++i) red[(wv * NB + i) * 64 + lane] = acc[i];
        __syncthreads();
        { const int i = tid >> 6; float s = 0.f;
#pragma unroll
          for (int w2 = 0; w2 < 8; ++w2) s += red[(w2 * NB + i) * 64 + lane];
          mod[i * 6 * D + col] = s + bias[col]; }
        __syncthreads();
    }
}

#define DPP_ADDF(x, ctrl) x += __uint_as_float(__builtin_amdgcn_update_dpp(0, __float_as_uint(x), ctrl, 0xf, 0xf, true))
__device__ __forceinline__ float red16(float x) { DPP_ADDF(x, 0xB1); DPP_ADDF(x, 0x4E); DPP_ADDF(x, 0x141); DPP_ADDF(x, 0x140); return x; }
__device__ __forceinline__ float red64(float x) {
    x = red16(x);
    { auto rr = __builtin_amdgcn_permlane16_swap(__float_as_uint(x), __float_as_uint(x), false, false); x = __uint_as_float(rr[0]) + __uint_as_float(rr[1]); }
    { auto rr = __builtin_amdgcn_permlane32_swap(__float_as_uint(x), __float_as_uint(x), false, false); x = __uint_as_float(rr[0]) + __uint_as_float(rr[1]); }
    return x;
}
__device__ __forceinline__ float fast_tanh(float x) { const float t = __expf(2.f * x); return 1.f - 2.f * __builtin_amdgcn_rcpf(t + 1.f); }
__device__ __forceinline__ float fast_sig(float x) { return __builtin_amdgcn_rcpf(1.f + __expf(-x)); }
__device__ __forceinline__ float fast_gelu(float x) { return 0.5f * x * (1.f + fast_tanh(0.7978845608028654f * (x + 0.044715f * x * x * x))); }

__device__ __forceinline__ void f_prep_gmlp(const Params& P, LAS unsigned char* lds, int tid) {
    typedef float f32x2 __attribute__((ext_vector_type(2)));
    const bf16_t* Pp = (const bf16_t*)(P.ws + WS_P);
    const float *mu = P.in[6], *w0 = P.in[7], *a0 = P.in[9], *k_k = P.in[12], *k_a = P.in[13], *r_k = P.in[14];
    const float *lng = P.in[17], *lnb = P.in[18], *wsp = P.in[19], *bsp = P.in[20];
    const bf16_t* w2t = (const bf16_t*)(P.ws + WS_LORA); const bf16_t* a2t = w2t + 512 * 64; const bf16_t* g2t = a2t + 512 * 64;
    bf16_t* SV = (bf16_t*)(P.ws + WS_SCANV);
    float* Gb = (float*)(P.ws + WS_G); float* bonus = (float*)(P.ws + WS_BONUS);
    bf16_t* O = (bf16_t*)(P.ws + WS_O);
    const int lane = tid & 63, w = __builtin_amdgcn_readfirstlane(tid >> 6), c16 = lane & 15, q4 = lane >> 4;
    constexpr int AST = 528;
    constexpr int VST = 272, VWAVE = 64 * VST;
    if (blockIdx.x < NTOK / 128) {
        const int unit = blockIdx.x; const int m0 = unit * 128;
        constexpr int ATILE = 16 * AST, CONST_OFF = 2 * ATILE, SCR0 = CONST_OFF + 16384, SCRW = 15104;
        constexpr int XS = 144;
        constexpr int O_XA = 0, O_XR = 2304, O_XB = 4608, O_XK = 6912, O_BN = 9216, O_BP = 10304, O_BQ = 11392, O_AT = 12480, O_ECL = 14784;
        static_assert(O_AT + 64 * 32 <= O_ECL && O_ECL + 256 <= SCRW && SCR0 + 8 * SCRW <= LDS_BYTES, "prep LDS map");
        {
            LAS float* cf = (LAS float*)(lds + CONST_OFF);
            const int cidx = tid;
            cf[cidx] = mu[cidx]; cf[512 + cidx] = mu[512 + cidx]; cf[1024 + cidx] = mu[1024 + cidx]; cf[1536 + cidx] = w0[cidx]; cf[2048 + cidx] = a0[cidx]; cf[2560 + cidx] = k_k[cidx]; cf[3072 + cidx] = k_a[cidx]; cf[3584 + cidx] = r_k[cidx];
        }
        const int a_row = tid >> 5, a_l32 = tid & 31, a_col8 = 8 * a_l32;
        float mu8[8];
#pragma unroll
        for (int e = 0; e < 8; ++e) mu8[e] = mu[1536 + a_col8 + e];
#define PREP_ATILE(mt_, buf_) do { const int m_ = m0 + 16 * (mt_) + a_row; \
            const u32x4 pc_ = *(const u32x4*)(Pp + (size_t)m_ * INC + 1536 + a_col8); u32x4 pp_ = (u32x4){0u, 0u, 0u, 0u}; \
            if (m_ % SEQ) pp_ = *(const u32x4*)(Pp + (size_t)(m_ - 1) * INC + 1536 + a_col8); \
            float v_[8]; \
            _Pragma("unroll") for (int e = 0; e < 8; ++e) { const float x_ = pg8::bfe(pc_, e), xp_ = pg8::bfe(pp_, e); const float xs_ = x_ + (xp_ - x_) * mu8[e]; \
                v_[e] = (a_l32 < 8) ? fast_tanh(xs_) : ((a_l32 < 16) ? xs_ : fast_sig(xs_)); } \
            u32x4 o_; o_.x = pg8::cvt_pk_bf16(v_[0], v_[1]); o_.y = pg8::cvt_pk_bf16(v_[2], v_[3]); o_.z = pg8::cvt_pk_bf16(v_[4], v_[5]); o_.w = pg8::cvt_pk_bf16(v_[6], v_[7]); \
            *(LAS u32x4*)(lds + (buf_) * ATILE + a_row * AST + a_col8 * 2) = o_; } while (0)
        PREP_ATILE(0, 0);
        __syncthreads();
        {
            const int colb = 64 * w + 4 * c16;
            const LAS f32x4* cst = (const LAS f32x4*)(lds + CONST_OFF) + (colb >> 2);
            const char* P8 = (const char*)Pp;
            LAS unsigned char* scr = lds + SCR0 + w * SCRW;
            const int bh = (m0 / SEQ) * 8 + w;
            unsigned char* opsb = ops_ptr(P, bh) + (size_t)((m0 % SEQ) / 16) * OPB;
#define PREP_LOAD(rr_, CR, CK, CV, QR, QK, QV) do { const int m_ = m0 + 16 * mt + 4 * q4 + (rr_); const unsigned pb_ = (unsigned)(m_ * INC + colb) * 2u; \
                CR = *(const uint2*)(P8 + pb_); CK = *(const uint2*)(P8 + pb_ + 1024u); CV = *(const uint2*)(P8 + pb_ + 2048u); QR = make_uint2(0u, 0u); QK = QR; QV = QR; \
                if (m_ % SEQ) { const unsigned qb_ = pb_ - (unsigned)(INC * 2); QR = *(const uint2*)(P8 + qb_); QK = *(const uint2*)(P8 + qb_ + 1024u); QV = *(const uint2*)(P8 + qb_ + 2048u); } } while (0)
            for (int mt = 0; mt < 8; ++mt) {
                if (mt + 1 < 8) PREP_ATILE(mt + 1, (mt + 1) & 1);
                uint2 cr, ck, cv, qr, qk, qv, ncr, nck, ncv, nqr, nqk, nqv;
                PREP_LOAD(0, cr, ck, cv, qr, qk, qv);
                f32x4 aw[4], aa[4], ag[4];
#pragma unroll
                for (int j = 0; j < 4; ++j) { aw[j] = (f32x4){0.f, 0.f, 0.f, 0.f}; aa[j] = aw[j]; ag[j] = aw[j]; }
                const LAS unsigned char* arow = lds + (mt & 1) * ATILE + c16 * AST + 16 * q4;
#pragma unroll
                for (int ks = 0; ks < 2; ++ks) {
                    const bf16x8 fw = *(const LAS bf16x8*)(arow + ks * 64), fa = *(const LAS bf16x8*)(arow + 128 + ks * 64);
#pragma unroll
                    for (int j = 0; j < 4; ++j) {
                        const bf16x8 bw = *(const bf16x8*)(w2t + (size_t)(colb + j) * 64 + ks * 32 + 8 * q4), ba = *(const bf16x8*)(a2t + (size_t)(colb + j) * 64 + ks * 32 + 8 * q4);
                        aw[j] = __builtin_amdgcn_mfma_f32_16x16x32_bf16(fw, bw, aw[j], 0, 0, 0);
                        aa[j] = __builtin_amdgcn_mfma_f32_16x16x32_bf16(fa, ba, aa[j], 0, 0, 0);
                    }
                }
#pragma unroll
                for (int ks = 0; ks < 4; ++ks) {
                    const bf16x8 fg = *(const LAS bf16x8*)(arow + 256 + ks * 64);
#pragma unroll
                    for (int j = 0; j < 4; ++j) { const bf16x8 bg = *(const bf16x8*)(g2t + (size_t)(colb + j) * 128 + ks * 32 + 8 * q4); ag[j] = __builtin_amdgcn_mfma_f32_16x16x32_bf16(fg, bg, ag[j], 0, 0, 0); }
                }
                float ta[4][4], tb[4][4], tk[4][4], tr[4][4], tl[4][4];
#pragma unroll
                for (int rr = 0; rr < 4; ++rr) {
                    const int m = m0 + 16 * mt + 4 * q4 + rr;
                    if (rr < 3) PREP_LOAD(rr + 1, ncr, nck, ncv, nqr, nqk, nqv);
                    const f32x4 mur = cst[0], muk = cst[128], muv = cst[256], w0v = cst[384], a0v = cst[512], kkv = cst[640], kav = cst[768], rkv = cst[896];
                    float v4[4], an[4], bn4[4];
                    float ss = 0.f, bsum = 0.f;
#pragma unroll
                    for (int j = 0; j < 4; ++j) {
                        const unsigned wr_ = (j < 2) ? cr.x : cr.y, wk_ = (j < 2) ? ck.x : ck.y, wv_ = (j < 2) ? cv.x : cv.y, pr_ = (j < 2) ? qr.x : qr.y, pk_ = (j < 2) ? qk.x : qk.y, pv_ = (j < 2) ? qv.x : qv.y;
                        const float xr = (j & 1) ? pg8::bfhi(wr_) : pg8::bflo(wr_), xk = (j & 1) ? pg8::bfhi(wk_) : pg8::bflo(wk_), xv = (j & 1) ? pg8::bfhi(wv_) : pg8::bflo(wv_);
                        const float yr = (j & 1) ? pg8::bfhi(pr_) : pg8::bflo(pr_), yk = (j & 1) ? pg8::bfhi(pk_) : pg8::bflo(pk_), yv = (j & 1) ? pg8::bfhi(pv_) : pg8::bflo(pv_);
                        const float r1 = xr + (yr - xr) * mur[j], k1 = xk + (yk - xk) * muk[j]; v4[j] = xv + (yv - xv) * muv[j];
                        const float z = -(w0v[j] + aw[j][rr]);
                        const float sp = fmaxf(z, 0.f) + __logf(1.f + __expf(-fabsf(z)));
                        tl[rr][j] = -__expf(-sp - 0.5f);
                        const float a = fast_sig(a0v[j] + aa[j][rr]);
                        const float kk = k1 * kkv[j];
                        ss += kk * kk;
                        tk[rr][j] = k1 * (1.f + (a - 1.f) * kav[j]);
                        tr[rr][j] = r1;
                        bsum += r1 * tk[rr][j] * rkv[j];
                        an[j] = kk; bn4[j] = a;
                    }
                    ss = red16(ss); bsum = red16(bsum);
                    const float rn = rsqrtf(fmaxf(ss, 1e-24f));
                    const unsigned ob = (unsigned)(m * CW + colb) * 4u;
                    f32x4 oV, oG;
#pragma unroll
                    for (int j = 0; j < 4; ++j) { const float kkn = an[j] * rn; ta[rr][j] = -kkn; tb[rr][j] = kkn * bn4[j]; oV[j] = v4[j]; oG[j] = ag[j][rr]; }
                    *(u32x2*)((char*)SV + (ob >> 1)) = (u32x2){pg8::cvt_pk_bf16(oV[0], oV[1]), pg8::cvt_pk_bf16(oV[2], oV[3])}; *(u32x2*)((char*)Gb + (ob >> 1)) = (u32x2){pg8::cvt_pk_bf16(oG[0], oG[1]), pg8::cvt_pk_bf16(oG[2], oG[3])};
                    if (c16 == 0) bonus[m * 8 + w] = bsum;
                    cr = ncr; ck = nck; cv = ncv; qr = nqr; qk = nqk; qv = nqv;
                }
                float cinc[4][4], cL[4];
#pragma unroll
                for (int j = 0; j < 4; ++j) {
                    float run = 0.f;
#pragma unroll
                    for (int rr = 0; rr < 4; ++rr) { run += tl[rr][j]; cinc[rr][j] = run; }
                    const float t1 = __shfl(run, (lane - 16) & 63), t2 = __shfl(run, (lane - 32) & 63), t3 = __shfl(run, (lane - 48) & 63);
                    const float off = (q4 >= 1 ? t1 : 0.f) + (q4 >= 2 ? t2 : 0.f) + (q4 >= 3 ? t3 : 0.f);
#pragma unroll
                    for (int rr = 0; rr < 4; ++rr) cinc[rr][j] += off;
                    cL[j] = __shfl(cinc[3][j], 48 + c16);
                }
#pragma unroll
                for (int rr = 0; rr < 4; ++rr) {
                    float xa[4], xr_[4], xb[4], xk[4];
#pragma unroll
                    for (int j = 0; j < 4; ++j) { const float ec = __expf(cinc[rr][j]), ecx = __expf(cinc[rr][j] - tl[rr][j]), en = __expf(-cinc[rr][j]);
                        xa[j] = ta[rr][j] * ecx; xr_[j] = tr[rr][j] * ec; xb[j] = tb[rr][j] * en; xk[j] = tk[rr][j] * en; }
                    LAS unsigned char* xp = scr + (4 * q4 + rr) * XS + c16 * 8;
                    *(LAS u32x2*)(xp + O_XA) = (u32x2){pg8::cvt_pk_bf16(xa[0], xa[1]), pg8::cvt_pk_bf16(xa[2], xa[3])};
                    *(LAS u32x2*)(xp + O_XR) = (u32x2){pg8::cvt_pk_bf16(xr_[0], xr_[1]), pg8::cvt_pk_bf16(xr_[2], xr_[3])};
                    *(LAS u32x2*)(xp + O_XB) = (u32x2){pg8::cvt_pk_bf16(xb[0], xb[1]), pg8::cvt_pk_bf16(xb[2], xb[3])};
                    *(LAS u32x2*)(xp + O_XK) = (u32x2){pg8::cvt_pk_bf16(xk[0], xk[1]), pg8::cvt_pk_bf16(xk[2], xk[3])};
                }
                if (q4 == 0) *(LAS f32x4*)(scr + O_ECL + c16 * 16) = (f32x4){__expf(cL[0]), __expf(cL[1]), __expf(cL[2]), __expf(cL[3])};
                asm volatile("s_waitcnt lgkmcnt(0)" ::: "memory");
#define SM_WR(off_, v_) do { _Pragma("unroll") for (int r_ = 0; r_ < 4; ++r_) *(LAS float*)(scr + (off_) + ((4 * q4 + r_) * 17 + c16) * 4) = (v_)[r_]; } while (0)
#define SM_A(off_, kk_) (*(const LAS float*)(scr + (off_) + (c16 * 17 + 4 * (kk_) + q4) * 4))
#define SM_B(off_, kk_) (*(const LAS float*)(scr + (off_) + ((4 * (kk_) + q4) * 17 + c16) * 4))
#define XV(off_, tok_, col_) bf2f(*(const LAS bf16_t*)(scr + (off_) + (tok_) * XS + (col_) * 2))
                f32x4 mN = (f32x4){0.f, 0.f, 0.f, 0.f}, mK = mN, mQb = mN, mQk = mN;
                {
                    const LAS unsigned char* rowp = scr + c16 * XS + 16 * q4;
#pragma unroll
                    for (int ks = 0; ks < 2; ++ks) {
                        const bf16x8 fa = *(const LAS bf16x8*)(rowp + O_XA + 64 * ks), fr = *(const LAS bf16x8*)(rowp + O_XR + 64 * ks), fb = *(const LAS bf16x8*)(rowp + O_XB + 64 * ks), fk = *(const LAS bf16x8*)(rowp + O_XK + 64 * ks);
                        mN = __builtin_amdgcn_mfma_f32_16x16x32_bf16(fb, fa, mN, 0, 0, 0); mK = __builtin_amdgcn_mfma_f32_16x16x32_bf16(fk, fa, mK, 0, 0, 0);
                        mQb = __builtin_amdgcn_mfma_f32_16x16x32_bf16(fb, fr, mQb, 0, 0, 0); mQk = __builtin_amdgcn_mfma_f32_16x16x32_bf16(fk, fr, mQk, 0, 0, 0);
                    }
#pragma unroll
                    for (int r_ = 0; r_ < 4; ++r_) { const int s_ = 4 * q4 + r_; if (!(s_ < c16)) { mN[r_] = 0.f; mK[r_] = 0.f; } if (!(s_ <= c16)) { mQb[r_] = 0.f; mQk[r_] = 0.f; } }
                }
#define SM_MUL(dst_, offA_, idA_, offB_, idB_) do { dst_ = (f32x4){0.f, 0.f, 0.f, 0.f}; _Pragma("unroll") for (int kk_ = 0; kk_ < 4; ++kk_) { \
                        float a_ = SM_A(offA_, kk_), b_ = SM_B(offB_, kk_); if ((idA_) && c16 == 4 * kk_ + q4) a_ += 1.f; if ((idB_) && c16 == 4 * kk_ + q4) b_ += 1.f; \
                        dst_ = __builtin_amdgcn_mfma_f32_16x16x4f32(a_, b_, dst_, 0, 0, 0); } } while (0)
#define LFENCE() asm volatile("s_waitcnt lgkmcnt(0)" ::: "memory")
                f32x4 t0, t1v, t2v;
                SM_WR(O_BN, mN); LFENCE();
                SM_MUL(t0, O_BN, false, O_BN, false);
                SM_WR(O_BP, t0); LFENCE();
                SM_MUL(t1v, O_BN, true, O_BP, true);
                SM_MUL(t2v, O_BP, false, O_BP, false);
                LFENCE(); SM_WR(O_BN, t2v); SM_WR(O_BQ, t1v); LFENCE();
                SM_MUL(t0, O_BN, false, O_BN, false);
                SM_MUL(t1v, O_BQ, false, O_BN, true);
                LFENCE(); SM_WR(O_BP, t0); SM_WR(O_BQ, t1v); LFENCE();
                SM_MUL(t2v, O_BQ, false, O_BP, true);
                LFENCE(); SM_WR(O_BN, t2v); SM_WR(O_BP, mK); LFENCE();
                {
                    f32x4 at[4];
#pragma unroll
                    for (int mt2 = 0; mt2 < 4; ++mt2) { at[mt2] = (f32x4){0.f, 0.f, 0.f, 0.f};
#pragma unroll
                        for (int kk = 0; kk < 4; ++kk) at[mt2] = __builtin_amdgcn_mfma_f32_16x16x4f32(XV(O_XA, 4 * kk + q4, 16 * mt2 + c16), SM_B(O_BN, kk), at[mt2], 0, 0, 0); }
                    SM_MUL(t0, O_BP, false, O_BN, false);
#pragma unroll
                    for (int mt2 = 0; mt2 < 4; ++mt2)
#pragma unroll
                        for (int r_ = 0; r_ < 4; ++r_) *(LAS bf16_t*)(scr + O_AT + (16 * mt2 + 4 * q4 + r_) * 32 + c16 * 2) = f2bf(at[mt2][r_]);
                    LFENCE(); SM_WR(O_BQ, t0); SM_WR(O_BP, mQb); LFENCE();
                }
#define AT_A(j_, kk_) bf2f(*(const LAS bf16_t*)(scr + O_AT + (j_) * 32 + (4 * (kk_) + q4) * 2))
                {
                    f32x4 ry[4];
#pragma unroll
                    for (int mt2 = 0; mt2 < 4; ++mt2) { ry[mt2] = (f32x4){0.f, 0.f, 0.f, 0.f};
#pragma unroll
                        for (int kk = 0; kk < 4; ++kk) ry[mt2] = __builtin_amdgcn_mfma_f32_16x16x4f32(AT_A(16 * mt2 + c16, kk), SM_B(O_BP, kk), ry[mt2], 0, 0, 0);
#pragma unroll
                        for (int r_ = 0; r_ < 4; ++r_) ry[mt2][r_] += XV(O_XR, c16, 16 * mt2 + 4 * q4 + r_); }
                    SM_MUL(t0, O_BQ, false, O_BP, false);
#pragma unroll
                    for (int r_ = 0; r_ < 4; ++r_) t0[r_] += mQk[r_];
#pragma unroll
                    for (int s2 = 0; s2 < 2; ++s2) { u32x4 o; o.x = pg8::cvt_pk_bf16(ry[2 * s2][0], ry[2 * s2][1]); o.y = pg8::cvt_pk_bf16(ry[2 * s2][2], ry[2 * s2][3]); o.z = pg8::cvt_pk_bf16(ry[2 * s2 + 1][0], ry[2 * s2 + 1][1]); o.w = pg8::cvt_pk_bf16(ry[2 * s2 + 1][2], ry[2 * s2 + 1][3]);
                        *(u32x4*)(opsb + (size_t)mt * OPB + 8192 + s2 * 1024 + lane * 16) = o; }
                    *(uint2*)(opsb + (size_t)mt * OPB + 12288 + lane * 8) = make_uint2(pg8::cvt_pk_bf16(t0[0], t0[1]), pg8::cvt_pk_bf16(t0[2], t0[3]));
                }
                {
                    u32x2 own[4];
#pragma unroll
                    for (int rr = 0; rr < 4; ++rr) own[rr] = *(const LAS u32x2*)(scr + O_XB + (4 * q4 + rr) * XS + c16 * 8);
                    LFENCE();
#pragma unroll
                    for (int j = 0; j < 4; ++j) { const unsigned w0_ = own[0][j >> 1], w1_ = own[1][j >> 1], w2_ = own[2][j >> 1], w3_ = own[3][j >> 1];
                        const unsigned e0 = (j & 1) ? (w0_ >> 16) : (w0_ & 0xffffu), e1 = (j & 1) ? (w1_ >> 16) : (w1_ & 0xffffu), e2 = (j & 1) ? (w2_ >> 16) : (w2_ & 0xffffu), e3 = (j & 1) ? (w3_ >> 16) : (w3_ & 0xffffu);
                        *(LAS u32x2*)(scr + O_XB + (4 * c16 + j) * 32 + q4 * 8) = (u32x2){e0 | (e1 << 16), e2 | (e3 << 16)}; }
                    LFENCE();
                    const bf16x8 zf = (bf16x8){0, 0, 0, 0, 0, 0, 0, 0};
                    bf16x8 fat[4], fmt = zf;
#pragma unroll
                    for (int mt2 = 0; mt2 < 4; ++mt2) fat[mt2] = (q4 < 2) ? *(const LAS bf16x8*)(scr + O_AT + (16 * mt2 + c16) * 32 + 16 * q4) : zf;
                    if (q4 < 2) { float mv[8];
#pragma unroll
                        for (int e = 0; e < 8; ++e) mv[e] = *(const LAS float*)(scr + O_BQ + (c16 * 17 + 8 * q4 + e) * 4);
                        u32x4 mu_; mu_.x = pg8::cvt_pk_bf16(mv[0], mv[1]); mu_.y = pg8::cvt_pk_bf16(mv[2], mv[3]); mu_.z = pg8::cvt_pk_bf16(mv[4], mv[5]); mu_.w = pg8::cvt_pk_bf16(mv[6], mv[7]);
                        fmt = __builtin_bit_cast(bf16x8, mu_); }
#pragma unroll 1
                    for (int nt = 0; nt < 4; ++nt) {
                        const float ecn = *(const LAS float*)(scr + O_ECL + (16 * nt + c16) * 4);
                        const bf16x8 fb = (q4 < 2) ? *(const LAS bf16x8*)(scr + O_XB + (16 * nt + c16) * 32 + 16 * q4) : zf;
                        const f32x4 z4 = (f32x4){0.f, 0.f, 0.f, 0.f};
                        f32x4 gt[4], hm;
#pragma unroll
                        for (int mt2 = 0; mt2 < 4; ++mt2) gt[mt2] = __builtin_amdgcn_mfma_f32_16x16x32_bf16(fat[mt2], fb, z4, 0, 0, 0);
                        hm = __builtin_amdgcn_mfma_f32_16x16x32_bf16(fmt, fb, z4, 0, 0, 0);
#pragma unroll
                        for (int mt2 = 0; mt2 < 4; ++mt2)
#pragma unroll
                            for (int r_ = 0; r_ < 4; ++r_) gt[mt2][r_] *= ecn;
#pragma unroll
                        for (int r_ = 0; r_ < 4; ++r_) { if (4 * q4 + r_ == c16) gt[nt][r_] += ecn; hm[r_] = (hm[r_] + XV(O_XK, 4 * q4 + r_, 16 * nt + c16)) * ecn; }
#pragma unroll
                        for (int s2 = 0; s2 < 2; ++s2) { u32x4 o; o.x = pg8::cvt_pk_bf16(gt[2 * s2][0], gt[2 * s2][1]); o.y = pg8::cvt_pk_bf16(gt[2 * s2][2], gt[2 * s2][3]); o.z = pg8::cvt_pk_bf16(gt[2 * s2 + 1][0], gt[2 * s2 + 1][1]); o.w = pg8::cvt_pk_bf16(gt[2 * s2 + 1][2], gt[2 * s2 + 1][3]);
                            *(u32x4*)(opsb + (size_t)mt * OPB + (nt * 2 + s2) * 1024 + lane * 16) = o; }
                        *(u32x2*)(opsb + (size_t)mt * OPB + 10240 + nt * 512 + lane * 8) = (u32x2){pg8::cvt_pk_bf16(hm[0], hm[1]), pg8::cvt_pk_bf16(hm[2], hm[3])};
                    }
                }
                LFENCE();
#undef AT_A
#undef LFENCE
#undef SM_MUL
#undef XV
#undef SM_B
#undef SM_A
#undef SM_WR
                __syncthreads();
            }
#undef PREP_LOAD
        }
#undef PREP_ATILE
        __syncthreads();
        const int lane_b = pg8::lane_now();
        {
            const int lane = lane_b;
            const float lg_ = lng[64 * w + lane], lb_ = lnb[64 * w + lane];
            LAS unsigned char* vrow = lds + w * VWAVE + lane * VST;
            const bf16_t* pv = Pp + (size_t)m0 * INC + RWC + CW + 64 * w + lane;
            bf16_t raw[8], nraw[8];
#pragma unroll
            for (int s = 0; s < 8; ++s) raw[s] = pv[(size_t)s * INC];
            for (int sb = 0; sb < 16; ++sb) {
                if (sb + 1 < 16) {
#pragma unroll
                    for (int s = 0; s < 8; ++s) nraw[s] = pv[(size_t)((sb + 1) * 8 + s) * INC];
                }
                float vn[8];
#pragma unroll
                for (int s = 0; s < 8; ++s) {
                    const float z = fast_gelu(bf2f(raw[s]));
                    const float mean = red64(z) * (1.f / 64.f); const float d = z - mean;
                    const float var = red64(d * d) * (1.f / 64.f);
                    vn[s] = d * rsqrtf(var + 1e-5f) * lg_ + lb_;
                }
                u32x4 o; o.x = pg8::cvt_pk_bf16(vn[0], vn[1]); o.y = pg8::cvt_pk_bf16(vn[2], vn[3]); o.z = pg8::cvt_pk_bf16(vn[4], vn[5]); o.w = pg8::cvt_pk_bf16(vn[6], vn[7]);
                *(LAS u32x4*)(vrow + sb * 16) = o;
#pragma unroll
                for (int s = 0; s < 8; ++s) raw[s] = nraw[s];
            }
        }
        asm volatile("s_waitcnt lgkmcnt(0)" ::: "memory");
        {
            const int c16 = lane_b & 15, q4 = lane_b >> 4;
            const float* wsg = wsp + (size_t)w * 16384;
            const LAS unsigned char* vb = lds + w * VWAVE + 16 * q4;
            for (int mt = 0; mt < 8; ++mt) {
                f32x4 acc[4];
#pragma unroll
                for (int j = 0; j < 4; ++j) acc[j] = (f32x4){0.f, 0.f, 0.f, 0.f};
                const int t_a = 16 * mt + c16;
                uint2 pu[4]; float bias[4];
#pragma unroll
                for (int rr = 0; rr < 4; ++rr) { const int tl = 16 * mt + 4 * q4 + rr; pu[rr] = *(const uint2*)(Pp + (size_t)(m0 + tl) * INC + RWC + 64 * w + 4 * c16); bias[rr] = bsp[w * 128 + tl]; }
                f32x4 x0[4], x1[4];
#pragma unroll
                for (int ks = 0; ks < 4; ++ks) if (ks <= mt / 2) { const int s0 = 32 * ks + 8 * q4; x0[ks] = *(const f32x4*)(wsg + (size_t)t_a * 128 + s0); x1[ks] = *(const f32x4*)(wsg + (size_t)t_a * 128 + s0 + 4); }
#pragma unroll
                for (int ks = 0; ks < 4; ++ks) if (ks <= mt / 2) {
                    const int s0 = 32 * ks + 8 * q4;
                    float xv[8] = {x0[ks][0], x0[ks][1], x0[ks][2], x0[ks][3], x1[ks][0], x1[ks][1], x1[ks][2], x1[ks][3]};
#pragma unroll
                    for (int e = 0; e < 8; ++e) if (s0 + e > t_a) xv[e] = 0.f;
                    u32x4 au; au.x = pg8::cvt_pk_bf16(xv[0], xv[1]); au.y = pg8::cvt_pk_bf16(xv[2], xv[3]); au.z = pg8::cvt_pk_bf16(xv[4], xv[5]); au.w = pg8::cvt_pk_bf16(xv[6], xv[7]);
                    const bf16x8 af = __builtin_bit_cast(bf16x8, au);
#pragma unroll
                    for (int j = 0; j < 4; ++j) { const bf16x8 bfr = *(const LAS bf16x8*)(vb + (4 * c16 + j) * VST + ks * 64); acc[j] = __builtin_amdgcn_mfma_f32_16x16x32_bf16(af, bfr, acc[j], 0, 0, 0); }
                }
#pragma unroll
                for (int rr = 0; rr < 4; ++rr) {
                    const int m = m0 + 16 * mt + 4 * q4 + rr;
                    const float u0 = fast_gelu(pg8::bflo(pu[rr].x)), u1 = fast_gelu(pg8::bfhi(pu[rr].x)), u2 = fast_gelu(pg8::bflo(pu[rr].y)), u3 = fast_gelu(pg8::bfhi(pu[rr].y));
                    if constexpr (MRG_F8) *(unsigned*)((unsigned char*)O + (size_t)m * D + CW + 64 * w + 4 * c16) = (unsigned)pk4_fp8(u0 * (acc[0][rr] + bias[rr]) * OGM_SCALE, u1 * (acc[1][rr] + bias[rr]) * OGM_SCALE, u2 * (acc[2][rr] + bias[rr]) * OGM_SCALE, u3 * (acc[3][rr] + bias[rr]) * OGM_SCALE);
                    else { uint2 ov; ov.x = pg8::cvt_pk_bf16(u0 * (acc[0][rr] + bias[rr]), u1 * (acc[1][rr] + bias[rr])); ov.y = pg8::cvt_pk_bf16(u2 * (acc[2][rr] + bias[rr]), u3 * (acc[3][rr] + bias[rr]));
                    *(uint2*)(O + (size_t)m * D + CW + 64 * w + 4 * c16) = ov; }
                }
            }
        }
        __syncthreads();
    }
}

__device__ __forceinline__ void f_post(const Params& P, const Ctx& c) {
    const bf16_t* V = (const bf16_t*)(P.ws + WS_SCANV); const float* Y = (const float*)(P.ws + WS_Y); const float* Gb = (const float*)(P.ws + WS_G);
    const float* bonus = (const float*)(P.ws + WS_BONUS); const float *lg = P.in[15], *lb = P.in[16];
    bf16_t* O = (bf16_t*)(P.ws + WS_O);
    const int l16 = c.lane & 15, sub = c.lane >> 4;
    for (int it = c.gwave; it < NTOK * 2; it += c.nwaves) {
        const int m = it >> 1, h = (it & 1) * 4 + sub, col = h * 64 + 4 * l16;
        const unsigned ob = (unsigned)(m * CW + col) * 4u;
        const u32x2 yb_ = *(const u32x2*)((const char*)Y + (ob >> 1)), gb_ = *(const u32x2*)((const char*)Gb + (ob >> 1)), vb_ = *(const u32x2*)((const char*)V + (ob >> 1));
        const f32x4 yv = (f32x4){pg8::bflo(yb_[0]), pg8::bfhi(yb_[0]), pg8::bflo(yb_[1]), pg8::bfhi(yb_[1])}, gv = (f32x4){pg8::bflo(gb_[0]), pg8::bfhi(gb_[0]), pg8::bflo(gb_[1]), pg8::bfhi(gb_[1])};
        const f32x4 vv = (f32x4){pg8::bflo(vb_[0]), pg8::bfhi(vb_[0]), pg8::bflo(vb_[1]), pg8::bfhi(vb_[1])};
        const f32x4 lgv = *(const f32x4*)(lg + col), lbv = *(const f32x4*)(lb + col);
        const float bn = bonus[m * 8 + h];
        const float mean = red16((yv[0] + yv[1]) + (yv[2] + yv[3])) * (1.f / 64.f);
        const f32x4 d = yv - mean;
        const float var = red16((d[0] * d[0] + d[1] * d[1]) + (d[2] * d[2] + d[3] * d[3])) * (1.f / 64.f);
        const float rs = rsqrtf(var + 64e-5f);
        float o[4];
#pragma unroll
        for (int j = 0; j < 4; ++j) o[j] = (d[j] * rs * lgv[j] + lbv[j] + bn * vv[j]) * gv[j];
        if constexpr (MRG_F8) *(unsigned*)((unsigned char*)O + (size_t)m * D + col) = (unsigned)pk4_fp8(o[0] * ORW_SCALE, o[1] * ORW_SCALE, o[2] * ORW_SCALE, o[3] * ORW_SCALE);
        else { uint2 ov; ov.x = pg8::cvt_pk_bf16(o[0], o[1]); ov.y = pg8::cvt_pk_bf16(o[2], o[3]);
        *(uint2*)(O + (size_t)m * D + col) = ov; }
    }
}

__global__ void __launch_bounds__(NT) fwd_kernel(Params P) {
    cg::grid_group grid = cg::this_grid();
#define MKTID() ({ int l_; asm volatile("v_mbcnt_lo_u32_b32 %0, -1, 0\n\tv_mbcnt_hi_u32_b32 %0, -1, %0" : "=v"(l_)); const int t_ = (s_wave << 6) | l_; t_; })
#define MKCTX() ({ Ctx c_; const int t_ = MKTID(); c_.tid = t_; c_.gtid = (long)blockIdx.x * NT + t_; c_.gthreads = (long)gridDim.x * NT; c_.gwave = (int)(c_.gtid >> 6); c_.nwaves = (int)(c_.gthreads >> 6); c_.lane = t_ & 63; c_; })
    bf16_t* H = (bf16_t*)(P.ws + WS_H); bf16_t* Pp = (bf16_t*)(P.ws + WS_P);
    const float* mod = (const float*)(P.ws + WS_MOD);
    extern __shared__ __attribute__((aligned(16))) unsigned char lds_raw[];
    LAS unsigned char* lds = (LAS unsigned char*)lds_raw;
    const int s_wave = __builtin_amdgcn_readfirstlane(threadIdx.x >> 6);
    LAS float* scr = (LAS float*)(lds + s_wave * 16384);
    volatile LAS unsigned* bst = (volatile LAS unsigned*)(lds + 131072 + 16384 + 7168);
    if (threadIdx.x == 0) { bst[0] = 0u; bst[1] = 0u; }
    __syncthreads();
    const XcdBarrier xbar = xcd_barrier_post((unsigned*)(P.ws + WS_CTL), bst, (int)threadIdx.x);
#define GSYNC() xcd_barrier(xbar, MKTID())
#define PH(k) for (int rep_ = 0; rep_ < (((PROBE_MASK >> (k)) & 1) ? PROBE_N : 1); ++rep_)

    PH(0) { f_mod(P, lds, MKTID()); __syncthreads(); }
    PH(1) { transpose_small(P, scr, MKCTX()); __syncthreads(); }
    if (P.ws == nullptr) grid.sync();
    GSYNC();
    PH(2) n_norm<(PG_F8 ? 2 : 0), false>(P, MKCTX(), P.in[0], P.in[4], 0, 1);
    GSYNC();
    PH(3) {
        pg8::DenseSched S; S.init(NTOK, INC, D, gridDim.x, blockIdx.x, P.ws + WS_WTIN, PG_F8 ? 1 : 2);
        pg8::EpiP E{Pp, INC};
        pg8::gemm_phase<pg8::EpiP, pg8::DenseSched, true, PG_F8>(lds, (const char*)H, D, S, E, MKTID());
        if ((int)blockIdx.x >= ((int)gridDim.x >> 1)) {
            Ctx c_ = MKCTX(); const int eb_ = (int)gridDim.x >> 1; c_.gwave -= eb_ * (NT / 64); c_.nwaves = ((int)gridDim.x - eb_) * (NT / 64);
            transpose_moe(P, lds, s_wave, c_, 0, CONV_EARLY);
        }
    }
    GSYNC();
    PH(4) f_prep_gmlp(P, lds, MKTID());
    GSYNC();
    PH(5) {
        if (blockIdx.x < NB * 8) f_scan(P, lds, MKTID());
        else {
            Ctx c_ = MKCTX(); c_.gwave -= NB * 8 * (NT / 64); c_.nwaves -= NB * 8 * (NT / 64);
            transpose_moe(P, lds, s_wave, c_, CONV_EARLY, NE * 192);
        }
    }
    GSYNC();
    PH(6) f_post(P, MKCTX());
    GSYNC();
    PH(8) {
        pg8::DenseSched S; S.init(NTOK, D, D, gridDim.x, blockIdx.x, P.ws + WS_WTBR, MRG_F8 ? 1 : 2);
        pg8::EpiMerge E{Pp, (bf16_t*)(P.ws + WS_Y)};
        pg8::gemm_phase<pg8::EpiMerge, pg8::DenseSched, true, MRG_F8>(lds, (const char*)(P.ws + WS_O), D, S, E, MKTID());
    }
    GSYNC();
    PH(9) {
        pg8::DenseSched S; S.init(NTOK, D, D, gridDim.x, blockIdx.x, P.ws + WS_WTOUT, OUT_F8 ? 1 : 2);
        pg8::EpiOut E{P.in[0], mod, (bf16_t*)(P.ws + WS_X1)};
        pg8::gemm_phase<pg8::EpiOut, pg8::DenseSched, true, OUT_F8>(lds, (const char*)(P.ws + WS_Y), D, S, E, MKTID());
    }
    GSYNC();
    PH(10) n_norm<(MOE1_F8 ? 1 : 0), true>(P, MKCTX(), P.ws + WS_X1, P.in[24], 3, 4);
    GSYNC();
    PH(11) {
        const int half = (int)gridDim.x >> 1;
        if ((int)blockIdx.x < half) {
            pg8::DenseSched S; S.init(NTOK, NE, D, half, blockIdx.x, P.ws + WS_WTRS);
            pg8::EpiRouter E{(float*)(P.ws + WS_G)};
            pg8::gemm_phase<pg8::EpiRouter, pg8::DenseSched, true>(lds, (const char*)H, D, S, E, MKTID());
        } else {
            pg8::DenseSched S; S.init(NTOK, 2 * ED, D, half, (int)blockIdx.x - half, P.ws + WS_WTRS + 512 * 1024, 1);
            pg8::EpiShared E{(bf16_t*)(P.ws + WS_ACTSH)};
            pg8::gemm_phase<pg8::EpiShared, pg8::DenseSched, true, true>(lds, (const char*)(P.ws + WS_H2F8), D, S, E, MKTID());
        }
    }
    GSYNC();
    PH(12) f_topk(P, (int*)(lds_raw + 131072 + 16384), MKTID());
    GSYNC();
    PH(13) f_route2(P, (int*)(lds_raw + 131072 + 16384), MKTID());
    GSYNC();
    PH(14) {
        const int* tile_e = (const int*)(P.ws + WS_TILE); const int ntiles = __builtin_amdgcn_readfirstlane(tile_e[6144]);
        pg8::MoeSched1 S{(const int*)(P.ws + WS_ROWTOK), tile_e, ntiles * 2, (int)gridDim.x, (int)blockIdx.x, (const char*)(P.ws + WS_WTGU)};
        pg8::EpiMoe1 E{(bf16_t*)(P.ws + WS_ACTP)};
        pg8::gemm_phase<pg8::EpiMoe1, pg8::MoeSched1, true, MOE1_F8>(lds, MOE1_F8 ? (const char*)(P.ws + WS_H2F8) : (const char*)H, D, S, E, MKTID());
    }
    GSYNC();
    PH(15) {
        const int* tile_e = (const int*)(P.ws + WS_TILE); const int ntiles = __builtin_amdgcn_readfirstlane(tile_e[6144]);
        pg8::MoeSched2 S{tile_e, ntiles * 4, (int)gridDim.x, (int)blockIdx.x, (const char*)(P.ws + WS_WTDN)};
        pg8::EpiMoe2 E{(bf16_t*)(P.ws + WS_YS), (const float*)(P.ws + WS_ROWW), P.ws + WS_G + (size_t)blockIdx.x * 1024};
        pg8::gemm_phase<pg8::EpiMoe2, pg8::MoeSched2, true, true>(lds, (const char*)(P.ws + WS_ACTP), ED, S, E, MKTID());
    }
    PH(16) {
        pg8::DenseSched S2; S2.init(NTOK, D, ED, gridDim.x, blockIdx.x, P.ws + WS_WTSHD);
        pg8::EpiYsh E2{(bf16_t*)(P.ws + WS_YSH)};
        pg8::gemm_phase<pg8::EpiYsh, pg8::DenseSched, true>(lds, (const char*)(P.ws + WS_ACTSH), ED, S2, E2, MKTID());
    }
    GSYNC();
    f_final(P, MKCTX());
}

extern "C" void kernel_launch(void* const* d_in, const int* in_sizes, int n_in, void* d_out, int out_size, void* d_ws, size_t ws_size, hipStream_t stream) {
    static int grid_blocks = 0;
    if (!grid_blocks) {
        int dev = 0, cus = 0, per_cu = 0;
        hipGetDevice(&dev);
        hipDeviceGetAttribute(&cus, hipDeviceAttributeMultiprocessorCount, dev);
        if (hipFuncSetAttribute((const void*)fwd_kernel, hipFuncAttributeMaxDynamicSharedMemorySize, LDS_BYTES) != hipSuccess) fprintf(stderr, "kernel_launch: hipFuncSetAttribute failed\n");
        if (hipOccupancyMaxActiveBlocksPerMultiprocessor(&per_cu, fwd_kernel, NT, LDS_BYTES) != hipSuccess || per_cu < 1) { fprintf(stderr, "kernel_launch: occupancy query says %d\n", per_cu); per_cu = 1; }
        (void)hipGetLastError();
        grid_blocks = cus;
        if (n_in != 34 || ws_size < WS_END) fprintf(stderr, "kernel_launch: unexpected n_in %d or ws_size %zu\n", n_in, ws_size);
    }
    (void)hipMemsetAsync((char*)d_ws + WS_CTL, 0, 65536, stream);
    Params p{};
    for (int i = 0; i < 34; ++i) p.in[i] = (const float*)d_in[i];
    p.out = (float*)d_out; p.ws = (unsigned char*)d_ws;
    void* args[] = {&p};
    hipError_t e = hipLaunchCooperativeKernel((void*)fwd_kernel, dim3(grid_blocks), dim3(NT), args, LDS_BYTES, stream);
    if (e != hipSuccess) fprintf(stderr, "cooperative launch failed: %s (grid %d)\n", hipGetErrorString(e), grid_blocks);
}
```

```cpp
#include <hip/hip_runtime.h>
#include <type_traits>
#include <hip/hip_cooperative_groups.h>
#include <cstdio>
#include <cstdint>
namespace cg = cooperative_groups;

typedef unsigned short bf16_t;
__device__ __forceinline__ float bf2f(bf16_t v) { return __uint_as_float((unsigned)v << 16); }
__device__ __forceinline__ bf16_t f2bf(float f) { unsigned u = __float_as_uint(f); return (bf16_t)((u + 0x7fffu + ((u >> 16) & 1u)) >> 16); }

constexpr int NB = 8, SEQ = 4096, D = 1024, NTOK = NB * SEQ;
constexpr int CW = 512;
constexpr int RWC = 1792, INC = 4864, GT_OFF = 2816;
constexpr int NE = 256, TOPK = 8, ED = 256;
constexpr int NPAIR = NTOK * TOPK;
#ifndef PROBE_MASK
#define PROBE_MASK 0
#define PROBE_N 1
#endif
constexpr bool MOE1_F8 = true;
constexpr bool OUT_F8 = true;
constexpr float MRG_SCALE = 32.f;
constexpr bool MRG_F8 = true;
constexpr float ORW_SCALE = 16.f, OGM_SCALE = 8.f;
constexpr bool GT_F8 = true;
constexpr bool PG_F8 = true;
constexpr float YS_SCALE = 16.f;
constexpr int NT = 512;
constexpr int LDS_BYTES = 155648;

constexpr size_t MiB = 1u << 20;
constexpr size_t WS_CTL = 0;
constexpr size_t WS_MOD = 1 * MiB;
constexpr size_t WS_BONUS = 2 * MiB;
constexpr size_t WS_TOKE = 3 * MiB;
constexpr size_t WS_TOKW = 4 * MiB;
constexpr size_t WS_TILE = 512 * 1024;
constexpr size_t WS_LORA = 768 * 1024;
constexpr size_t WS_BLKCNT = 5 * MiB;
constexpr size_t WS_TOKLP = 6 * MiB;
constexpr size_t WS_TOKDEST = 7 * MiB;
constexpr size_t WS_ROWTOK = 8 * MiB;
constexpr size_t WS_ROWW = 10 * MiB;
constexpr size_t WS_BK2 = 8 * MiB;
constexpr size_t WS_WTIN = 12 * MiB;
constexpr size_t WS_WTBR = 22 * MiB;
constexpr size_t WS_WTOUT = 24 * MiB;
constexpr size_t WS_WTRS = 26 * MiB;
constexpr size_t WS_WTSHD = 27 * MiB + 512 * 1024;
constexpr size_t WS_WTDN = 28 * MiB;
constexpr size_t WS_WTGU = 156 * MiB;
constexpr size_t WS_YS = 156 * MiB;
constexpr size_t WS_YSH = 844 * MiB;
constexpr size_t WS_X1 = 476 * MiB;
constexpr size_t WS_H2F8 = 972 * MiB;
constexpr size_t WS_GT = 92 * MiB;
constexpr size_t WS_ACTP = 668 * MiB;
constexpr size_t WS_SCANV = 437 * MiB;
constexpr size_t OPS_BH = (size_t)(SEQ / 16) * 12800;
constexpr int OPB = 12800;
constexpr size_t WS_H = 412 * MiB;
constexpr size_t WS_O = 476 * MiB;
constexpr size_t WS_P = 540 * MiB;
constexpr size_t WS_Y = 844 * MiB;
constexpr size_t WS_G = 908 * MiB;
constexpr size_t WS_ACTSH = 940 * MiB;
constexpr size_t WS_VN = WS_H;
constexpr size_t WS_ACT = 668 * MiB;
constexpr size_t WS_END = 1024 * MiB;

__device__ __forceinline__ int pk4_fp8(float a, float b, float c, float d) {
    a = __builtin_fminf(__builtin_fmaxf(a, -448.f), 448.f); b = __builtin_fminf(__builtin_fmaxf(b, -448.f), 448.f); c = __builtin_fminf(__builtin_fmaxf(c, -448.f), 448.f); d = __builtin_fminf(__builtin_fmaxf(d, -448.f), 448.f);
    int r = __builtin_amdgcn_cvt_pk_fp8_f32(a, b, 0, false); return __builtin_amdgcn_cvt_pk_fp8_f32(c, d, r, true);
}
struct Params {
    const float* in[34];
    float* out;
    unsigned char* ws;
};

__device__ __forceinline__ unsigned char* ops_ptr(const Params& P, int bh) {
    return bh < 40 ? (unsigned char*)P.out + (size_t)bh * OPS_BH : (bh < 56 ? P.ws + 972 * MiB + (size_t)(bh - 40) * OPS_BH : P.ws + 412 * MiB + (size_t)(bh - 56) * OPS_BH);
}
__device__ __forceinline__ float wave_sum(float v) {
#pragma unroll
    for (int o = 32; o; o >>= 1) v += __shfl_xor(v, o);
    return v;
}
__device__ __forceinline__ float sigmoidf_(float x) { return 1.f / (1.f + expf(-x)); }
__device__ __forceinline__ float siluf_(float x) { return x / (1.f + expf(-x)); }
__device__ __forceinline__ float geluf_(float x) { return 0.5f * x * (1.f + tanhf(0.7978845608028654f * (x + 0.044715f * x * x * x))); }

struct Ctx { long gtid, gthreads; int gwave, nwaves, lane, tid; };

template <int MODE, bool XBF16>
__device__ __forceinline__ void n_norm(const Params& P, const Ctx& c, const void* xin, const float* g, int sh_idx, int sc_idx) {
    typedef float f32x4_ __attribute__((ext_vector_type(4)));
    typedef unsigned u32x2_ __attribute__((ext_vector_type(2)));
    const float* mod = (const float*)(P.ws + WS_MOD);
    bf16_t* H = (bf16_t*)(P.ws + WS_H);
    for (int m = c.gwave; m < NTOK; m += c.nwaves) {
        f32x4_ v[4]; float ss = 0.f;
#pragma unroll
        for (int i = 0; i < 4; ++i) {
            if (XBF16) { const u32x2_ r_ = *(const u32x2_*)((const bf16_t*)xin + (size_t)m * D + 4 * c.lane + 256 * i); v[i] = (f32x4_){__uint_as_float(r_[0] << 16), __uint_as_float(r_[0] & 0xffff0000u), __uint_as_float(r_[1] << 16), __uint_as_float(r_[1] & 0xffff0000u)}; }
            else v[i] = *(const f32x4_*)((const float*)xin + (size_t)m * D + 4 * c.lane + 256 * i);
            ss += (v[i][0] * v[i][0] + v[i][1] * v[i][1]) + (v[i][2] * v[i][2] + v[i][3] * v[i][3]); }
        ss = wave_sum(ss);
        const float rstd = rsqrtf(ss * (1.f / D) + 1e-6f);
        const float* mb = mod + (size_t)(m / SEQ) * 6 * D;
#pragma unroll
        for (int i = 0; i < 4; ++i) { const int j = 4 * c.lane + 256 * i;
            const f32x4_ gv = *(const f32x4_*)(g + j), scv = *(const f32x4_*)(mb + sc_idx * D + j), shv = *(const f32x4_*)(mb + sh_idx * D + j);
            float hv[4];
#pragma unroll
            for (int q = 0; q < 4; ++q) hv[q] = v[i][q] * rstd * gv[q] * (1.f + scv[q]) + shv[q];
            if (MODE != 2) *(u32x2_*)(H + (size_t)m * D + j) = (u32x2_){(unsigned)f2bf(hv[0]) | ((unsigned)f2bf(hv[1]) << 16), (unsigned)f2bf(hv[2]) | ((unsigned)f2bf(hv[3]) << 16)};
            if (MODE != 0) { const int pk = pk4_fp8(hv[0] * 2.f, hv[1] * 2.f, hv[2] * 2.f, hv[3] * 2.f);
                *(int*)(P.ws + (MODE == 1 ? WS_H2F8 : WS_H) + (size_t)m * D + j) = pk; }
        }
    }
}

#define LAS __attribute__((address_space(3)))
typedef short bf16x8 __attribute__((ext_vector_type(8)));
typedef float f32x4 __attribute__((ext_vector_type(4)));
typedef unsigned u32x4 __attribute__((ext_vector_type(4)));
typedef unsigned u32x2 __attribute__((ext_vector_type(2)));
typedef int i32x8 __attribute__((ext_vector_type(8)));
typedef int i32x4 __attribute__((ext_vector_type(4)));
namespace pg8 {
constexpr int BM = 256, BK = 64, HALF = 128, HTB = HALF * BK * 2, STAGE_BYTES = 8 * HTB, NXCD = 8, WGM = 8;
constexpr unsigned PRE_OFF = STAGE_BYTES + 10 * 2048;
__device__ __forceinline__ int lds_byte(int r, int c) { const int st = (r >> 4) * 2 + (c >> 5), rr = r & 15, cc = c & 31, ob = rr * 64 + cc * 2; return st * 1024 + (ob ^ (((ob >> 9) & 1) << 5)); }
__device__ __forceinline__ void stage_rc(int b, int& R, int& C) { const int st = b / 1024, sb = b % 1024, swz = sb ^ (((sb >> 9) & 1) << 5); R = (st >> 1) * 16 + swz / 64; C = (st & 1) * 32 + (swz % 64) / 2; }
__device__ __forceinline__ int perm32(int rho) { const int n = rho >> 4, i = rho & 15; return 8 * (i >> 2) + 4 * n + (i & 3); }
__device__ __forceinline__ unsigned cvt_pk_bf16(float lo, float hi) { unsigned r; asm volatile("v_cvt_pk_bf16_f32 %0, %1, %2" : "=v"(r) : "v"(lo), "v"(hi)); return r; }

__device__ __forceinline__ int lane_now() { int l_; asm volatile("v_mbcnt_lo_u32_b32 %0, -1, 0\n\tv_mbcnt_hi_u32_b32 %0, -1, %0" : "=v"(l_)); return l_; }
struct Unit { int pm, pn, aux, aux2; };
__device__ __forceinline__ const int* uni_ptr(const int* p) { const unsigned long g_ = (unsigned long)p; return (const int*)(((unsigned long)(unsigned)__builtin_amdgcn_readfirstlane((int)(g_ >> 32)) << 32) | (unsigned long)(unsigned)__builtin_amdgcn_readfirstlane((int)g_)); }
__device__ __forceinline__ int sload1(const int* p) { int v; asm volatile("s_load_dword %0, %1, 0x0\n\ts_waitcnt lgkmcnt(0)" : "=s"(v) : "s"(uni_ptr(p)) : "memory"); return v; }
__device__ __forceinline__ void sload3(const int* p0, const int* p1, const int* p2, int& a, int& b, int& c) {
    asm volatile("s_load_dword %0, %3, 0x0\n\ts_load_dword %1, %4, 0x0\n\ts_load_dword %2, %5, 0x0\n\ts_waitcnt lgkmcnt(0)" : "=&s"(a), "=&s"(b), "=&s"(c) : "s"(uni_ptr(p0)), "s"(uni_ptr(p1)), "s"(uni_ptr(p2)) : "memory"); }

struct DenseSched {
    int nM, nN, nwg, G, c, K; const char* Bt;
    __device__ void init(int M, int N, int K_, int G_, int c_, const void* Bt_, int esz = 2) { nM = M / BM; nN = N / BM; nwg = nM * nN; G = G_; c = c_; K = K_ * esz; Bt = (const char*)Bt_; }
    __device__ __forceinline__ bool next(int i, Unit& u) const {
        const long L = (long)i * G + c; if (L >= nwg) return false;
        int wgid = (int)L; { const int q = nwg / NXCD, r = nwg % NXCD, xcd = wgid % NXCD, off = wgid / NXCD; wgid = (xcd < r ? xcd * (q + 1) : r * (q + 1) + (xcd - r) * q) + off; }
        const int nig = WGM * nN, gid = wgid / nig, fm = gid * WGM, gsz = (nM - fm) < WGM ? (nM - fm) : WGM;
        u.pm = fm + ((wgid % nig) % gsz); u.pn = (wgid % nig) / gsz; u.aux = 0; u.aux2 = 0; return true;
    }
    __device__ __forceinline__ unsigned a_off(const Unit& u, int r) const { return (unsigned)(u.pm * BM + r) * (unsigned)K; }
    __device__ __forceinline__ const char* b_ptr(const Unit& u) const { return Bt + (size_t)u.pn * BM * K; }
};

template <class Epi, class Sched, bool ALIGN_EPI, bool F8 = false>
__device__ __forceinline__ void gemm_phase(LAS unsigned char* lds, const char* Abase, const int K, const Sched& S, const Epi& E, int tid) {
    asm volatile("" : "+v"(tid));
    const int wid = __builtin_amdgcn_readfirstlane(tid >> 6), lane = tid & 63, wr = wid >> 2, wc = wid & 3, fr = lane & 15, fq = lane >> 4;
    const int nt = F8 ? K / 128 : K / BK;
    unsigned voffB_[2];
#pragma unroll
    for (int i = 0; i < 2; ++i) { int sR, sC; stage_rc(tid * 16 + i * 8192, sR, sC); const int Rb = Epi::PERM ? ((sR & ~31) + perm32(sR & 31)) : sR; voffB_[i] = F8 ? (unsigned)(Rb * K + sC * 2) : (unsigned)(Rb * K + sC) * 2u; }
    const size_t kstep = (size_t)(BK * 2);
    const size_t hstepB = (size_t)HALF * K * (F8 ? 1 : 2);
    const unsigned ldsw = (unsigned)wid * 1024u;
    const unsigned slotaddr = (unsigned)(unsigned long)lds + (unsigned)STAGE_BYTES + (unsigned)tid * 4u;
    const unsigned ldsbase = (unsigned)(unsigned long)lds;
    const int lp = F8 ? lds_byte(fr, 32 * (fq >> 1) + 16 * (fq & 1)) + 16 * (fq & 1) : lds_byte(fr, fq * 8);
    const unsigned aU = (unsigned)(unsigned long)lds + (unsigned)wr * 8192u, bU = (unsigned)(unsigned long)lds + (unsigned)wc * 4096u;
    volatile LAS unsigned* myslot = (volatile LAS unsigned*)(lds + STAGE_BYTES) + tid;
    myslot[8 * 512] = voffB_[0]; myslot[9 * 512] = voffB_[1];
    struct VB_ { volatile LAS unsigned* p; __device__ __forceinline__ unsigned operator[](int i) const { return p[(8 + i) * 512]; } } voffB{myslot};
#define PG8_FILL(par, u) do { const int _t = (wid << 6) | lane_now(); _Pragma("unroll") for (int _i = 0; _i < 2; ++_i) { int _R, _C; stage_rc(_t * 16 + _i * 8192, _R, _C); \
        _Pragma("unroll") for (int _h = 0; _h < 2; ++_h) myslot[((par) * 4 + _h * 2 + _i) * 512] = S.a_off(u, _h * HALF + _R) + (unsigned)_C * 2u; } } while (0)
#define PG8_SA(b, h) (((b) * 2 + (h)) * HTB)
#define PG8_SB(b, h) ((4 + (b) * 2 + (h)) * HTB)
#define PG8_STAGE(bufoff, gbase, voff) do { _Pragma("unroll") for (int _i = 0; _i < 2; ++_i) \
        __builtin_amdgcn_global_load_lds((const unsigned*)((const char*)(gbase) + (voff)[_i]), (LAS unsigned*)(lds + (bufoff) + ldsw + _i * 8192), 16, 0, 0); } while (0)
#define PG8_STAGE_A(bufoff, gbase, par, h) do { _Pragma("unroll") for (int _i = 0; _i < 2; ++_i) { const unsigned _o = myslot[((par) * 4 + (h) * 2 + _i) * 512]; \
        __builtin_amdgcn_global_load_lds((const unsigned*)((const char*)(gbase) + _o), (LAS unsigned*)(lds + (bufoff) + ldsw + _i * 8192), 16, 0, 0); } } while (0)
#define PG8_RD(dst, par, e) asm volatile("v_lshl_add_u32 %0, %2, 13, %1\n\tds_read_b32 %0, %0 offset:%3" : "=&v"(dst) : "v"(slotaddr), "s"((unsigned)(par)), "n"((e) * 2048) : "memory")
#define PG8_DMA1(ldsaddr, gbase, off) asm volatile("s_mov_b32 m0, %0\n\ts_nop 0\n\tglobal_load_lds_dwordx4 %1, %2" :: "s"(ldsaddr), "v"(off), "s"(gbase) : "memory", "m0")
#define PG8_STAGE_O(bufoff, gbase, o0, o1) do { const unsigned _la = ldsbase + (unsigned)(bufoff) + ldsw; const unsigned long _g = (unsigned long)(gbase); const char* _gb = (const char*)(((unsigned long)(unsigned)__builtin_amdgcn_readfirstlane((int)(_g >> 32)) << 32) | (unsigned long)(unsigned)__builtin_amdgcn_readfirstlane((int)_g)); PG8_DMA1(_la, _gb, o0); PG8_DMA1(_la + 8192u, _gb, o1); } while (0)
#define PG8_STAGE_B(bufoff, gbase, o0) do { const unsigned _la = ldsbase + (unsigned)(bufoff) + ldsw; const unsigned long _g = (unsigned long)(gbase); const char* _gb = (const char*)(((unsigned long)(unsigned)__builtin_amdgcn_readfirstlane((int)(_g >> 32)) << 32) | (unsigned long)(unsigned)__builtin_amdgcn_readfirstlane((int)_g)); PG8_DMA1(_la, _gb, o0); PG8_DMA1(_la + 8192u, _gb + (hstepB >> 1), o0); } while (0)
#define PG8_LDA(dst, b, h) do { unsigned a0_, a1_; asm volatile("v_add_u32 %0, %1, %2" : "=v"(a0_) : "s"(aU + (unsigned)PG8_SA(b, h)), "v"(lp)); a1_ = a0_; if constexpr (F8) asm volatile("v_xor_b32 %0, 16, %0" : "+v"(a1_)); _Pragma("unroll") for (int m = 0; m < 4; ++m) _Pragma("unroll") for (int k = 0; k < 2; ++k) dst[m][k] = *(const LAS bf16x8*)(unsigned long)((F8 ? (k ? a1_ : a0_) : a0_ + k * 1024) + m * 2048); } while (0)
#define PG8_LDB(dst, b, h) do { unsigned b0_, b1_; asm volatile("v_add_u32 %0, %1, %2" : "=v"(b0_) : "s"(bU + (unsigned)PG8_SB(b, h)), "v"(lp)); b1_ = b0_; if constexpr (F8) asm volatile("v_xor_b32 %0, 16, %0" : "+v"(b1_)); _Pragma("unroll") for (int n = 0; n < 2; ++n) _Pragma("unroll") for (int k = 0; k < 2; ++k) dst[n][k] = *(const LAS bf16x8*)(unsigned long)((F8 ? (k ? b1_ : b0_) : b0_ + k * 1024) + n * 2048); } while (0)
#define PG8_MMA(ai, bj, At, Bt) do { __builtin_amdgcn_s_setprio(1); _Pragma("unroll") for (int m = 0; m < 4; ++m) _Pragma("unroll") for (int n = 0; n < 2; ++n) { \
        if constexpr (F8) { acc[ai][bj][m][n] = __builtin_amdgcn_mfma_scale_f32_16x16x128_f8f6f4( \
                __builtin_shufflevector(__builtin_bit_cast(i32x4, Bt[n][0]), __builtin_bit_cast(i32x4, Bt[n][1]), 0, 1, 2, 3, 4, 5, 6, 7), \
                __builtin_shufflevector(__builtin_bit_cast(i32x4, At[m][0]), __builtin_bit_cast(i32x4, At[m][1]), 0, 1, 2, 3, 4, 5, 6, 7), acc[ai][bj][m][n], 0, 0, 0, Epi::SC_W, 0, Epi::SC_X); } \
        else { _Pragma("unroll") for (int k = 0; k < 2; ++k) acc[ai][bj][m][n] = __builtin_amdgcn_mfma_f32_16x16x32_bf16(Bt[n][k], At[m][k], acc[ai][bj][m][n], 0, 0, 0); } } \
        __builtin_amdgcn_s_setprio(0); } while (0)
#define PG8_WAIT_V(n) asm volatile("s_waitcnt vmcnt(" #n ")" ::: "memory")
#define PG8_WAIT_V2(nst) asm volatile("s_waitcnt vmcnt(%0)" :: "n"(8 + (nst)) : "memory")
#define PG8_WAIT_L(n) asm volatile("s_waitcnt lgkmcnt(" #n ")" ::: "memory")
#define PG8_BAR __builtin_amdgcn_s_barrier()
#define PG8_SCHED __builtin_amdgcn_sched_barrier(0)
    Unit cur, nxt; int ui = 0, p3 = 0;
    if (!S.next(0, cur)) return;
    f32x4 acc[2][2][4][2];
#pragma unroll
    for (int a = 0; a < 2; ++a)
#pragma unroll
        for (int b = 0; b < 2; ++b)
#pragma unroll
            for (int m = 0; m < 4; ++m)
#pragma unroll
                for (int n = 0; n < 2; ++n) acc[a][b][m][n] = (f32x4){0.f, 0.f, 0.f, 0.f};
    bf16x8 At[4][2], B0[2][2], B1[2][2];
    PG8_FILL(0, cur);
    if constexpr (Epi::HAS_PRE) E.pre(cur.pm, ldsbase + PRE_OFF, wid);
    const char* cB = S.b_ptr(cur);
    PG8_STAGE(PG8_SB(0, 0), cB, voffB); PG8_STAGE(PG8_SB(0, 1), cB + hstepB, voffB); PG8_STAGE_A(PG8_SA(0, 0), Abase, 0, 0); PG8_STAGE_A(PG8_SA(0, 1), Abase, 0, 1);
    if (wr == 1) PG8_BAR;
    PG8_WAIT_V(2); PG8_BAR;
    PG8_STAGE(PG8_SB(1, 0), cB + kstep, voffB); PG8_STAGE_A(PG8_SA(1, 0), Abase + kstep, 0, 0);
    if constexpr (Epi::NST > 0) PG8_WAIT_V(0); else PG8_WAIT_V(4);
    PG8_BAR;
    for (;;) {
        const bool has_next = S.next(ui + 1, nxt);
        const char* nB = has_next ? S.b_ptr(nxt) : cB;
        const int pc = ui & 1, pn_ = has_next ? (pc ^ 1) : pc;
        const int n3 = (p3 == 2) ? 0 : p3 + 1;
        if (has_next) PG8_FILL(pc ^ 1, nxt);
        if constexpr (Epi::HAS_PRE) E.pre(has_next ? nxt.pm : cur.pm, ldsbase + PRE_OFF + (unsigned)n3 * 1024u, wid);
#define PG8_KITER(t, WAITR) do { \
            const bool last = (t == nt - 2); \
            unsigned tk = (unsigned)t * (unsigned)kstep; asm volatile("" : "+s"(tk)); \
            const char* a1 = Abase + tk + kstep; const char* b1 = cB + tk + kstep; \
            const char* a2 = last ? Abase : Abase + tk + 2 * kstep; const char* b2 = last ? nB : cB + tk + 2 * kstep; \
            const char* a3 = a2 + kstep; const char* b3 = b2 + kstep; \
            const int p2 = last ? pn_ : pc; \
            if constexpr (Epi::HAS_MID) { if (t == nt / 2) { Unit um = cur; asm volatile("" : "+v"(um.pm), "+v"(um.pn)); um.pm = __builtin_amdgcn_readfirstlane(um.pm); um.pn = __builtin_amdgcn_readfirstlane(um.pn); const int l2_ = lane_now(); E.mid(acc, um, wr, wc, l2_ & 15, l2_ >> 4); } } \
            { unsigned ob0, oa0, oa1; PG8_RD(ob0, 0, 8); PG8_RD(oa0, pc, 2); PG8_RD(oa1, pc, 3); \
              PG8_LDB(B0, 0, 0); PG8_LDB(B1, 0, 1); PG8_SCHED; PG8_LDA(At, 0, 0); PG8_SCHED; PG8_WAIT_L(15); PG8_STAGE_B(PG8_SB(1, 1), b1 + hstepB, ob0); PG8_STAGE_O(PG8_SA(1, 1), a1, oa0, oa1); } \
            WAITR; PG8_WAIT_L(0); PG8_BAR; PG8_MMA(0, 0, At, B0); PG8_MMA(0, 1, At, B1); PG8_BAR; PG8_SCHED; \
            { unsigned ob0, oa0, oa1; PG8_RD(ob0, 0, 8); PG8_RD(oa0, p2, 0); PG8_RD(oa1, p2, 1); \
              PG8_LDA(At, 0, 1); PG8_SCHED; PG8_WAIT_L(8); PG8_STAGE_B(PG8_SB(0, 0), b2, ob0); PG8_STAGE_O(PG8_SA(0, 0), a2, oa0, oa1); } \
            PG8_WAIT_V(6); PG8_WAIT_L(0); PG8_BAR; PG8_MMA(1, 0, At, B0); PG8_MMA(1, 1, At, B1); PG8_BAR; PG8_SCHED; \
            { unsigned ob0, oa0, oa1; PG8_RD(ob0, 0, 8); PG8_RD(oa0, p2, 2); PG8_RD(oa1, p2, 3); \
              PG8_LDB(B0, 1, 0); PG8_LDB(B1, 1, 1); PG8_SCHED; PG8_LDA(At, 1, 0); PG8_SCHED; PG8_WAIT_L(15); PG8_STAGE_B(PG8_SB(0, 1), b2 + hstepB, ob0); PG8_STAGE_O(PG8_SA(0, 1), a2, oa0, oa1); } \
            PG8_WAIT_V(8); PG8_WAIT_L(0); PG8_BAR; PG8_MMA(0, 0, At, B0); PG8_MMA(0, 1, At, B1); PG8_BAR; PG8_SCHED; \
            { unsigned ob0, oa0, oa1; PG8_RD(ob0, 0, 8); PG8_RD(oa0, p2, 0); PG8_RD(oa1, p2, 1); \
              PG8_LDA(At, 1, 1); PG8_SCHED; PG8_WAIT_L(8); PG8_STAGE_B(PG8_SB(1, 0), b3, ob0); PG8_STAGE_O(PG8_SA(1, 0), a3, oa0, oa1); } \
            PG8_WAIT_V(6); PG8_WAIT_L(0); PG8_BAR; PG8_MMA(1, 0, At, B0); PG8_MMA(1, 1, At, B1); PG8_BAR; PG8_SCHED; \
        } while (0)
        if constexpr (Epi::NST > 0) {
            PG8_KITER(0, PG8_WAIT_V2(Epi::NST));
#pragma unroll 1
            for (int t = 2; t < nt; t += 2) PG8_KITER(t, PG8_WAIT_V(8));
        } else {
#pragma unroll 1
            for (int t = 0; t < nt; t += 2) PG8_KITER(t, PG8_WAIT_V(8));
        }
#undef PG8_KITER
#pragma unroll
        for (int a = 0; a < 2; ++a)
#pragma unroll
            for (int b = 0; b < 2; ++b)
#pragma unroll
                for (int m = 0; m < 4; ++m) asm volatile("" : "+v"(acc[a][b][m][0]), "+v"(acc[a][b][m][1]));
        if constexpr (ALIGN_EPI) { if (wr == 0) PG8_BAR; }
        {
            Unit ue = cur; asm volatile("" : "+v"(ue.pm), "+v"(ue.pn), "+v"(ue.aux), "+v"(ue.aux2));
            ue.pm = __builtin_amdgcn_readfirstlane(ue.pm); ue.pn = __builtin_amdgcn_readfirstlane(ue.pn); ue.aux = __builtin_amdgcn_readfirstlane(ue.aux); ue.aux2 = __builtin_amdgcn_readfirstlane(ue.aux2);
            const int l2_ = lane_now();
            if constexpr (Epi::HAS_PRE) E(acc, ue, wr, wc, l2_ & 15, l2_ >> 4, ldsbase + PRE_OFF + (unsigned)p3 * 1024u); else E(acc, ue, wr, wc, l2_ & 15, l2_ >> 4);
        }
        if (!has_next) break;
#pragma unroll
        for (int a = 0; a < 2; ++a)
#pragma unroll
            for (int b = 0; b < 2; ++b)
#pragma unroll
                for (int m = 0; m < 4; ++m)
#pragma unroll
                    for (int n = 0; n < 2; ++n) acc[a][b][m][n] = (f32x4){0.f, 0.f, 0.f, 0.f};
        cur = nxt; cB = nB; ++ui; p3 = n3;
        if constexpr (ALIGN_EPI) { if (wr == 1) PG8_BAR; }
    }
    PG8_WAIT_V(0);
    if constexpr (!ALIGN_EPI) { if (wr == 0) PG8_BAR; }
    PG8_BAR;
#undef PG8_FILL
#undef PG8_RD
#undef PG8_STAGE_O
#undef PG8_STAGE_B
#undef PG8_DMA1
#undef PG8_STAGE_A
#undef PG8_SA
#undef PG8_SB
#undef PG8_STAGE
#undef PG8_LDA
#undef PG8_LDB
#undef PG8_MMA
#undef PG8_WAIT_V
#undef PG8_WAIT_V2
#undef PG8_WAIT_L
#undef PG8_BAR
#undef PG8_SCHED
}

struct EpiP {
    static constexpr int SC_W = 0x7f7f7f7f, SC_X = 0x7f7f7f7f;
    static constexpr bool PERM = true, HAS_MID = false, HAS_PRE = false; static constexpr int NST = GT_F8 ? 8 : 16;
    bf16_t* O; int ldc; unsigned char* GT;
    __device__ __forceinline__ void operator()(const f32x4 (&acc)[2][2][4][2], const Unit& u, int wr, int wc, int fr, int fq) const {
        const int row0 = u.pm * BM + wr * 64 + fr, col0 = u.pn * BM + wc * 32 + 8 * fq;
        if (GT_F8 && u.pn * BM >= GT_OFF) {
            const int gcol = u.pn * BM - GT_OFF + wc * 32 + 8 * (fq & ~1) + HALF * (fq & 1);
#pragma unroll
            for (int ai = 0; ai < 2; ++ai)
#pragma unroll
                for (int m = 0; m < 4; ++m) { unsigned pk[2][2];
#pragma unroll
                    for (int bj = 0; bj < 2; ++bj) { float s[8];
#pragma unroll
                        for (int e = 0; e < 8; ++e) s[e] = 256.f * __builtin_amdgcn_rcpf(1.f + __expf(-acc[ai][bj][m][e >> 2][e & 3] * (PG_F8 ? 0.0078125f : 1.f)));
                        pk[bj][0] = (unsigned)pk4_fp8(s[0], s[1], s[2], s[3]); pk[bj][1] = (unsigned)pk4_fp8(s[4], s[5], s[6], s[7]); }
                    const auto sl = __builtin_amdgcn_permlane16_swap(pk[0][0], pk[1][0], false, false);
                    const auto sh = __builtin_amdgcn_permlane16_swap(pk[0][1], pk[1][1], false, false);
                    *(u32x4*)(GT + (size_t)(row0 + ai * HALF + m * 16) * 2048 + gcol) = (u32x4){sl[0], sh[0], sl[1], sh[1]}; }
            return;
        }
#pragma unroll
        for (int ai = 0; ai < 2; ++ai)
#pragma unroll
            for (int m = 0; m < 4; ++m) { bf16_t* rowp = O + (size_t)(row0 + ai * HALF + m * 16) * ldc + col0;
#pragma unroll
                for (int bj = 0; bj < 2; ++bj) { f32x4 v0 = acc[ai][bj][m][0] * (PG_F8 ? 0.0078125f : 1.f), v1 = acc[ai][bj][m][1] * (PG_F8 ? 0.0078125f : 1.f);
                    if (!GT_F8 && u.pn * BM >= GT_OFF) {
#pragma unroll
                        for (int q = 0; q < 4; ++q) { v0[q] = __builtin_amdgcn_rcpf(1.f + __expf(-v0[q])); v1[q] = __builtin_amdgcn_rcpf(1.f + __expf(-v1[q])); } }
                    u32x4 w; w.x = cvt_pk_bf16(v0[0], v0[1]); w.y = cvt_pk_bf16(v0[2], v0[3]); w.z = cvt_pk_bf16(v1[0], v1[1]); w.w = cvt_pk_bf16(v1[2], v1[3]);
                    *(u32x4*)(rowp + bj * HALF) = w; } }
    }
};
}

__device__ __forceinline__ unsigned pk2(float lo, float hi) { return (unsigned)f2bf(lo) | ((unsigned)f2bf(hi) << 16); }
__device__ __forceinline__ void transpose_item(const float* W, int N, bf16_t* WT, int ldt, LAS float* scr, int k0s, int k0d, int n0, int row0, int lane) {
#pragma unroll 8
    for (int i = 0; i < 32; ++i) { const int kk = 2 * i + (lane >> 5); scr[kk * 33 + (lane & 31)] = W[(size_t)(k0s + kk) * N + n0 + (lane & 31)]; }
    asm volatile("s_waitcnt lgkmcnt(0)" ::: "memory");
    const int c = lane & 7;
#pragma unroll
    for (int j = 0; j < 4; ++j) { const int n = (lane >> 3) + 8 * j; const LAS float* s = scr + (8 * c) * 33 + n;
        u32x4 o; o.x = pk2(s[0 * 33], s[1 * 33]); o.y = pk2(s[2 * 33], s[3 * 33]); o.z = pk2(s[4 * 33], s[5 * 33]); o.w = pk2(s[6 * 33], s[7 * 33]);
        *(u32x4*)(WT + (size_t)(row0 + n) * ldt + k0d + 8 * c) = o; }
    asm volatile("s_waitcnt lgkmcnt(0)" ::: "memory");
}
__device__ __forceinline__ void transpose_item_f8(const float* W, int N, unsigned char* WT, int ldt, LAS float* scr, int k0s, int k0d, int n0, int row0, int lane, float scale) {
#pragma unroll 8
    for (int i = 0; i < 32; ++i) { const int kk = 2 * i + (lane >> 5); scr[kk * 33 + (lane & 31)] = W[(size_t)(k0s + kk) * N + n0 + (lane & 31)] * scale; }
    asm volatile("s_waitcnt lgkmcnt(0)" ::: "memory");
    const int c = lane & 7;
#pragma unroll
    for (int j = 0; j < 4; ++j) { const int n = (lane >> 3) + 8 * j; const LAS float* s = scr + (8 * c) * 33 + n;
        const int lo = pk4_fp8(s[0 * 33], s[1 * 33], s[2 * 33], s[3 * 33]), hi = pk4_fp8(s[4 * 33], s[5 * 33], s[6 * 33], s[7 * 33]);
        *(u32x2*)(WT + (size_t)(row0 + n) * ldt + k0d + 8 * c) = (u32x2){(unsigned)lo, (unsigned)hi}; }
    asm volatile("s_waitcnt lgkmcnt(0)" ::: "memory");
}
__device__ __forceinline__ void transpose_small(const Params& P, LAS float* scr, const Ctx& c) {
    bf16_t* WTIN = (bf16_t*)(P.ws + WS_WTIN); bf16_t* WTBR = (bf16_t*)(P.ws + WS_WTBR); bf16_t* WTOUT = (bf16_t*)(P.ws + WS_WTOUT); bf16_t* WTRS = (bf16_t*)(P.ws + WS_WTRS); bf16_t* WTSHD = (bf16_t*)(P.ws + WS_WTSHD);
    constexpr int I_IN = 16 * 152, I_BR = 8 * 32, I_OUT = 16 * 32, I_R = 16 * 8, I_SD = 4 * 32, I_L = 16;
    constexpr int TOTAL = I_IN + 2 * I_BR + I_OUT + 3 * I_R + I_SD + 4 * I_L;
    bf16_t* W2T = (bf16_t*)(P.ws + WS_LORA); bf16_t* A2T = W2T + 512 * 64; bf16_t* G2T = A2T + 512 * 64;
    for (int it = c.gwave; it < TOTAL; it += c.nwaves) {
        int r = it;
        if (r < I_IN) { const int kb = r / 152, nb = r % 152;
            if (PG_F8) transpose_item_f8(P.in[5], INC, (unsigned char*)WTIN, D, scr, 64 * kb, 64 * kb, 32 * nb, 32 * nb, c.lane, 64.f);
            else transpose_item(P.in[5], INC, WTIN, D, scr, 64 * kb, 64 * kb, 32 * nb, 32 * nb, c.lane);
            continue; } r -= I_IN;
        if (r < I_BR) { const int kb = r / 32, nb = r % 32; if (MRG_F8) transpose_item_f8(P.in[21], D, (unsigned char*)WTBR, D, scr, 64 * kb, 64 * kb, 32 * nb, 32 * nb, c.lane, 64.f); else transpose_item(P.in[21], D, WTBR, D, scr, 64 * kb, 64 * kb, 32 * nb, 32 * nb, c.lane); continue; } r -= I_BR;
        if (r < I_BR) { const int kb = r / 32, nb = r % 32; if (MRG_F8) transpose_item_f8(P.in[22], D, (unsigned char*)WTBR, D, scr, 64 * kb, CW + 64 * kb, 32 * nb, 32 * nb, c.lane, 64.f); else transpose_item(P.in[22], D, WTBR, D, scr, 64 * kb, CW + 64 * kb, 32 * nb, 32 * nb, c.lane); continue; } r -= I_BR;
        if (r < I_OUT) { const int kb = r / 32, nb = r % 32; if (OUT_F8) transpose_item_f8(P.in[23], D, (unsigned char*)WTOUT, D, scr, 64 * kb, 64 * kb, 32 * nb, 32 * nb, c.lane, 64.f); else transpose_item(P.in[23], D, WTOUT, D, scr, 64 * kb, 64 * kb, 32 * nb, 32 * nb, c.lane); continue; } r -= I_OUT;
        if (r < I_R) { const int kb = r / 8, nb = r % 8; transpose_item(P.in[25], NE, WTRS, D, scr, 64 * kb, 64 * kb, 32 * nb, 32 * nb, c.lane); continue; } r -= I_R;
        if (r < I_R) { const int kb = r / 8, nb = r % 8, n0 = 32 * nb; transpose_item_f8(P.in[30], ED, P.ws + WS_WTRS + 512 * 1024, D, scr, 64 * kb, 64 * kb, n0, n0 < 128 ? n0 : 256 + (n0 - 128), c.lane, 64.f); continue; } r -= I_R;
        if (r < I_R) { const int kb = r / 8, nb = r % 8, n0 = 32 * nb; transpose_item_f8(P.in[31], ED, P.ws + WS_WTRS + 512 * 1024, D, scr, 64 * kb, 64 * kb, n0, n0 < 128 ? 128 + n0 : 384 + (n0 - 128), c.lane, 64.f); continue; } r -= I_R;
        if (r < I_SD) { const int kb = r / 32, nb = r % 32; transpose_item(P.in[32], D, WTSHD, ED, scr, 64 * kb, 64 * kb, 32 * nb, 32 * nb, c.lane); continue; } r -= I_SD;
        if (r < I_L) { transpose_item(P.in[8], CW, W2T, 64, scr, 0, 0, 32 * r, 32 * r, c.lane); continue; } r -= I_L;
        if (r < I_L) { transpose_item(P.in[10], CW, A2T, 64, scr, 0, 0, 32 * r, 32 * r, c.lane); continue; } r -= I_L;
        { const int kb = r / 16, nb = r % 16; transpose_item(P.in[11], CW, G2T, 128, scr, 64 * kb, 64 * kb, 32 * nb, 32 * nb, c.lane); }
    }
}
struct MoeItem { const float* W; unsigned char* WT; int N, ldt, k0, n0, row0; float scale; };
__device__ __forceinline__ MoeItem moe_item(const Params& P, int sup, int half) {
    unsigned char* WTGU = P.ws + WS_WTGU; unsigned char* WTDN = P.ws + WS_WTDN;
    const int e = sup / 192; int r = sup % 192; MoeItem m;
    if (r < 128) { const int up = r >> 6; r &= 63; const int kb = 2 * (r / 8) + half, n0 = 32 * (r % 8);
        m.W = (up ? P.in[28] : P.in[27]) + (size_t)e * D * ED; m.N = ED; m.WT = WTGU + (size_t)e * 512 * D; m.ldt = D; m.k0 = 64 * kb; m.n0 = n0; m.row0 = (n0 < 128 ? n0 : 256 + (n0 - 128)) + 128 * up; m.scale = 64.f; }
    else { r -= 128; const int kb = 2 * (r / 32) + half, n0 = 32 * (r % 32);
        m.W = P.in[29] + (size_t)e * ED * D; m.N = D; m.WT = WTDN + (size_t)e * D * ED; m.ldt = ED; m.k0 = 64 * kb; m.n0 = n0; m.row0 = n0; m.scale = 32.f; }
    return m;
}
__device__ __forceinline__ void moe_item_dma(const MoeItem& m, int lane, unsigned buf) {
    const unsigned voff = (unsigned)((lane >> 3) * m.N + 4 * (lane & 7)) * 4u;
    const unsigned long g_ = (unsigned long)(m.W + (size_t)m.k0 * m.N + m.n0);
    const char* gb = (const char*)(((unsigned long)(unsigned)__builtin_amdgcn_readfirstlane((int)(g_ >> 32)) << 32) | (unsigned long)(unsigned)__builtin_amdgcn_readfirstlane((int)g_));
    const unsigned step = (unsigned)__builtin_amdgcn_readfirstlane(m.N) * 32u, b0 = (unsigned)__builtin_amdgcn_readfirstlane((int)buf);
#pragma unroll
    for (int ci = 0; ci < 8; ++ci)
        asm volatile("s_mov_b32 m0, %0\n\ts_nop 0\n\tglobal_load_lds_dwordx4 %1, %2" :: "s"(b0 + (unsigned)ci * 1056u), "v"(voff), "s"(gb + (size_t)ci * step) : "memory", "m0");
}
__device__ __forceinline__ void moe_pair_out(const MoeItem& m, int lane, unsigned bufb) {
    const int c = lane & 7;
#pragma unroll
    for (int j = 0; j < 4; ++j) { const int n = (lane >> 3) + 8 * j;
        const LAS float* s = (const LAS float*)(unsigned long)(bufb + (unsigned)(c >> 2) * 8448u + (unsigned)(2 * (c & 3)) * 1056u + (unsigned)n * 4u);
        float f[16];
#pragma unroll
        for (int i = 0; i < 16; ++i) f[i] = s[(i >> 3) * 264 + (i & 7) * 32] * m.scale;
        u32x4 o; o.x = (unsigned)pk4_fp8(f[0], f[1], f[2], f[3]); o.y = (unsigned)pk4_fp8(f[4], f[5], f[6], f[7]); o.z = (unsigned)pk4_fp8(f[8], f[9], f[10], f[11]); o.w = (unsigned)pk4_fp8(f[12], f[13], f[14], f[15]);
        *(u32x4*)(m.WT + (size_t)(m.row0 + n) * m.ldt + m.k0 + 16 * c) = o; }
    asm volatile("s_waitcnt lgkmcnt(0)" ::: "memory");
}
__device__ __forceinline__ void transpose_moe(const Params& P, LAS unsigned char* lds, int wv, const Ctx& c) {
    static_assert(MOE1_F8, "expert weights are converted to fp8 only");
    const int NSUP = NE * 192;
    const unsigned bufb = (unsigned)(unsigned long)lds + (unsigned)wv * 17408u;
    for (int sup = c.gwave; sup < NSUP; sup += c.nwaves) {
        const MoeItem m0 = moe_item(P, sup, 0), m1 = moe_item(P, sup, 1);
        moe_item_dma(m0, c.lane, bufb); moe_item_dma(m1, c.lane, bufb + 8448u);
        asm volatile("s_waitcnt vmcnt(0)" ::: "memory");
        moe_pair_out(m0, c.lane, bufb);
    }
}

namespace pg8 {
__device__ __forceinline__ float bflo(unsigned u) { return __uint_as_float(u << 16); }
__device__ __forceinline__ float bfhi(unsigned u) { return __uint_as_float(u & 0xffff0000u); }
__device__ __forceinline__ float bfe(const u32x4& v, int e) { const unsigned w = v[e >> 1]; return (e & 1) ? bfhi(w) : bflo(w); }
__device__ __forceinline__ float f8e(const u32x2& v, int e) { typedef float f32x2_ __attribute__((ext_vector_type(2))); const f32x2_ p = (e & 2) ? __builtin_amdgcn_cvt_pk_f32_fp8((int)v[e >> 2], true) : __builtin_amdgcn_cvt_pk_f32_fp8((int)v[e >> 2], false); return p[e & 1]; }
__device__ __forceinline__ float fsig(float x) { return __builtin_amdgcn_rcpf(1.f + __expf(-x)); }

struct EpiMerge {
    static constexpr int SC_W = 0x7f7f7f7f, SC_X = 0x7f7f7f7f;
    static constexpr bool PERM = true, HAS_MID = true, HAS_PRE = false; static constexpr int NST = 0;
    const bf16_t* Pp; bf16_t* O; const unsigned char* GT;
    static __device__ __forceinline__ float g2e(const u32x4& v, int e) { return bfe(v, e); }
    static __device__ __forceinline__ float g2e(const u32x2& v, int e) { return f8e(v, e) * (1.f / 256.f); }
    __device__ __forceinline__ void mid(f32x4 (&acc)[2][2][4][2], const Unit& u, int wr, int wc, int fr, int fq) const {
        const int row0 = u.pm * BM + wr * 64 + fr, col0 = u.pn * BM + wc * 32 + 8 * fq;
#pragma unroll
        for (int ai = 0; ai < 2; ++ai) {
            if constexpr (GT_F8) {
                u32x2 x1[4][2], x2[4][2];
#pragma unroll
                for (int m = 0; m < 4; ++m) { const unsigned char* pr = GT + (size_t)(row0 + ai * HALF + m * 16) * 2048 + col0;
#pragma unroll
                    for (int bj = 0; bj < 2; ++bj) { x1[m][bj] = *(const u32x2*)(pr + bj * HALF); x2[m][bj] = *(const u32x2*)(pr + D + bj * HALF); } }
#pragma unroll
                for (int m = 0; m < 4; ++m)
#pragma unroll
                    for (int bj = 0; bj < 2; ++bj)
#pragma unroll
                        for (int e = 0; e < 8; ++e) { const float ratio = f8e(x1[m][bj], e) * __builtin_amdgcn_rcpf(f8e(x2[m][bj], e)) * (MRG_F8 ? OGM_SCALE / ORW_SCALE : 1.f); acc[ai][bj][m][e >> 2][e & 3] *= ratio; }
            } else {
            u32x4 x1[4][2], x2[4][2];
#pragma unroll
            for (int m = 0; m < 4; ++m) { const bf16_t* pr = Pp + (size_t)(row0 + ai * HALF + m * 16) * INC + GT_OFF + col0;
#pragma unroll
                for (int bj = 0; bj < 2; ++bj) { x1[m][bj] = *(const u32x4*)(pr + bj * HALF); x2[m][bj] = *(const u32x4*)(pr + D + bj * HALF); } }
#pragma unroll
            for (int m = 0; m < 4; ++m)
#pragma unroll
                for (int bj = 0; bj < 2; ++bj)
#pragma unroll
                    for (int e = 0; e < 8; ++e) { const float ratio = bfe(x1[m][bj], e) * __builtin_amdgcn_rcpf(bfe(x2[m][bj], e)) * (MRG_F8 ? OGM_SCALE / ORW_SCALE : 1.f); acc[ai][bj][m][e >> 2][e & 3] *= ratio; }
            }
            asm volatile("" ::: "memory");
        }
    }
    __device__ __forceinline__ void operator()(const f32x4 (&acc)[2][2][4][2], const Unit& u, int wr, int wc, int fr, int fq) const {
        const int row0 = u.pm * BM + wr * 64 + fr, col0 = u.pn * BM + wc * 32 + 8 * fq;
#pragma unroll
        for (int ai = 0; ai < 2; ++ai) {
            typename std::conditional<GT_F8, u32x2, u32x4>::type x2[4][2];
#pragma unroll
            for (int m = 0; m < 4; ++m)
#pragma unroll
                for (int bj = 0; bj < 2; ++bj) { typedef typename std::conditional<GT_F8, u32x2, u32x4>::type X2T; const void* gp_ = GT_F8 ? (const void*)(GT + (size_t)(row0 + ai * HALF + m * 16) * 2048 + D + col0 + bj * HALF) : (const void*)(Pp + (size_t)(row0 + ai * HALF + m * 16) * INC + GT_OFF + D + col0 + bj * HALF); x2[m][bj] = *(const X2T*)gp_; }
#pragma unroll
            for (int m = 0; m < 4; ++m) { const size_t r = (size_t)(row0 + ai * HALF + m * 16);
                if constexpr (OUT_F8) {
                    unsigned pk[2][2];
#pragma unroll
                    for (int bj = 0; bj < 2; ++bj) { float v[8];
#pragma unroll
                        for (int e = 0; e < 8; ++e) v[e] = acc[ai][bj][m][e >> 2][e & 3] * g2e(x2[m][bj], e) * (MRG_F8 ? MRG_SCALE / (OGM_SCALE * 64.f) : MRG_SCALE);
                        pk[bj][0] = (unsigned)pk4_fp8(v[0], v[1], v[2], v[3]); pk[bj][1] = (unsigned)pk4_fp8(v[4], v[5], v[6], v[7]); }
                    const auto sl = __builtin_amdgcn_permlane16_swap(pk[0][0], pk[1][0], false, false);
                    const auto sh = __builtin_amdgcn_permlane16_swap(pk[0][1], pk[1][1], false, false);
                    *(u32x4*)((unsigned char*)O + r * D + (u.pn * BM + wc * 32 + 8 * (fq & ~1) + HALF * (fq & 1))) = (u32x4){sl[0], sh[0], sl[1], sh[1]};
                } else {
#pragma unroll
                for (int bj = 0; bj < 2; ++bj) { float v[8];
#pragma unroll
                    for (int e = 0; e < 8; ++e) v[e] = acc[ai][bj][m][e >> 2][e & 3] * g2e(x2[m][bj], e) * (MRG_F8 ? 1.f / (OGM_SCALE * 64.f) : 1.f);
                    u32x4 w; w.x = cvt_pk_bf16(v[0], v[1]); w.y = cvt_pk_bf16(v[2], v[3]); w.z = cvt_pk_bf16(v[4], v[5]); w.w = cvt_pk_bf16(v[6], v[7]);
                    *(u32x4*)(O + r * D + col0 + bj * HALF) = w; } } }
            asm volatile("" ::: "memory");
        }
    }
};
struct EpiOut {
    static constexpr int SC_W = 0x7f7f7f7f, SC_X = 0x7f7f7f7f;
    static constexpr bool PERM = true, HAS_MID = false, HAS_PRE = false; static constexpr int NST = 0;
    const float* x; const float* mod; bf16_t* out;
    __device__ __forceinline__ void operator()(const f32x4 (&acc)[2][2][4][2], const Unit& u, int wr, int wc, int fr, int fq) const {
        const int row0 = u.pm * BM + wr * 64 + fr, col0 = u.pn * BM + wc * 32 + 8 * fq;
        const float* gt = mod + (size_t)((u.pm * BM) / SEQ) * 6 * D + 2 * D;
#pragma unroll
        for (int bj = 0; bj < 2; ++bj) { const int col = col0 + bj * HALF; const f32x4 g0 = *(const f32x4*)(gt + col) * (OUT_F8 ? 1.f / (MRG_SCALE * 64.f) : 1.f), g1 = *(const f32x4*)(gt + col + 4) * (OUT_F8 ? 1.f / (MRG_SCALE * 64.f) : 1.f);
#pragma unroll
            for (int ai = 0; ai < 2; ++ai)
#pragma unroll
                for (int m = 0; m < 4; ++m) { const size_t o = (size_t)(row0 + ai * HALF + m * 16) * D + col; const f32x4 x0 = *(const f32x4*)(x + o), x1 = *(const f32x4*)(x + o + 4);
                    const f32x4 v0 = x0 + g0 * acc[ai][bj][m][0], v1 = x1 + g1 * acc[ai][bj][m][1];
                    u32x4 w; w.x = cvt_pk_bf16(v0[0], v0[1]); w.y = cvt_pk_bf16(v0[2], v0[3]); w.z = cvt_pk_bf16(v1[0], v1[1]); w.w = cvt_pk_bf16(v1[2], v1[3]);
                    *(u32x4*)(out + o) = w; }
            asm volatile("" ::: "memory"); }
    }
};
struct EpiRouter {
    static constexpr int SC_W = 0x7f7f7f7f, SC_X = 0x7f7f7f7f;
    static constexpr bool PERM = true, HAS_MID = false, HAS_PRE = false; static constexpr int NST = 0;
    float* LG;
    __device__ __forceinline__ void operator()(const f32x4 (&acc)[2][2][4][2], const Unit& u, int wr, int wc, int fr, int fq) const {
        const int row0 = u.pm * BM + wr * 64 + fr;
#pragma unroll
        for (int ai = 0; ai < 2; ++ai)
#pragma unroll
            for (int m = 0; m < 4; ++m) { float* rp = LG + (size_t)(row0 + ai * HALF + m * 16) * NE + wc * 32 + 8 * fq;
#pragma unroll
                for (int bj = 0; bj < 2; ++bj) { *(f32x4*)(rp + bj * HALF) = acc[ai][bj][m][0]; *(f32x4*)(rp + bj * HALF + 4) = acc[ai][bj][m][1]; } }
    }
};
struct EpiShared {
    static constexpr int SC_W = 0x7f7f7f7f, SC_X = 0x7f7f7f7f;
    static constexpr bool PERM = true, HAS_MID = false, HAS_PRE = false; static constexpr int NST = 0;
    bf16_t* ASH;
    __device__ __forceinline__ void operator()(const f32x4 (&acc)[2][2][4][2], const Unit& u, int wr, int wc, int fr, int fq) const {
        const int row0 = u.pm * BM + wr * 64 + fr, j0 = 128 * u.pn + wc * 32 + 8 * fq;
#pragma unroll
        for (int ai = 0; ai < 2; ++ai)
#pragma unroll
            for (int m = 0; m < 4; ++m) { float v[8];
#pragma unroll
                for (int e = 0; e < 8; ++e) { const float g = acc[ai][0][m][e >> 2][e & 3] * 0.0078125f, up = acc[ai][1][m][e >> 2][e & 3] * 0.0078125f; v[e] = g * fsig(g) * up; }
                u32x4 w; w.x = cvt_pk_bf16(v[0], v[1]); w.y = cvt_pk_bf16(v[2], v[3]); w.z = cvt_pk_bf16(v[4], v[5]); w.w = cvt_pk_bf16(v[6], v[7]);
                *(u32x4*)(ASH + (size_t)(row0 + ai * HALF + m * 16) * ED + j0) = w; }
    }
};

struct MoeSched1 {
    const int* row_tok; const int* tile_e; int nunits, G, c; const char* W;
    __device__ __forceinline__ bool next(int i, Unit& u) const { const int L = i * G + c; if (L >= nunits) return false; u.pm = L >> 1; u.pn = L & 1; u.aux = sload1(tile_e + u.pm); u.aux2 = 0; return true; }
    __device__ __forceinline__ unsigned a_off(const Unit& u, int r) const { return (unsigned)row_tok[u.pm * BM + r] * (unsigned)(D * (MOE1_F8 ? 1 : 2)); }
    __device__ __forceinline__ const char* b_ptr(const Unit& u) const { return W + ((size_t)u.aux * 512 + (size_t)u.pn * 256) * (D * (MOE1_F8 ? 1 : 2)); }
};
struct EpiMoe1 {
    static constexpr bool PERM = true, HAS_MID = false, HAS_PRE = false; static constexpr int NST = 0; static constexpr int SC_W = 0x7f7f7f7f, SC_X = 0x7f7f7f7f;
    bf16_t* ACT;
    __device__ __forceinline__ void operator()(const f32x4 (&acc)[2][2][4][2], const Unit& u, int wr, int wc, int fr, int fq) const {
        const int row0 = u.pm * BM + wr * 64 + fr, j0 = 128 * u.pn + wc * 32 + 8 * fq;
#pragma unroll
        for (int ai = 0; ai < 2; ++ai)
#pragma unroll
            for (int m = 0; m < 4; ++m) { float v[8];
#pragma unroll
                for (int e = 0; e < 8; ++e) { const float g = acc[ai][0][m][e >> 2][e & 3] * (MOE1_F8 ? 0.0078125f : 1.f), up = acc[ai][1][m][e >> 2][e & 3] * ((MOE1_F8 ? 0.0078125f : 1.f) * 16.f); v[e] = g * fsig(g) * up; }
                const int lo = pk4_fp8(v[0], v[1], v[2], v[3]), hi = pk4_fp8(v[4], v[5], v[6], v[7]);
                *(u32x2*)((unsigned char*)ACT + (size_t)(row0 + ai * HALF + m * 16) * ED + j0) = (u32x2){(unsigned)lo, (unsigned)hi}; }
    }
};
struct MoeSched2 {
    const int* tile_e; int nunits, G, c; const char* W;
    __device__ __forceinline__ bool next(int i, Unit& u) const { const int L = i * G + c; if (L >= nunits) return false; u.pm = L >> 2; u.pn = L & 3; int cb_, va_; sload3(tile_e + u.pm, tile_e + 2048 + u.pm, tile_e + 4096 + u.pm, u.aux, cb_, va_); u.aux2 = cb_ | (va_ << 20); return true; }
    __device__ __forceinline__ unsigned a_off(const Unit& u, int r) const { return (unsigned)(u.pm * BM + r) * (unsigned)ED; }
    __device__ __forceinline__ const char* b_ptr(const Unit& u) const { return W + ((size_t)u.aux * D + (size_t)u.pn * 256) * ED; }
};
struct EpiMoe2 {
    static constexpr bool PERM = true, HAS_MID = false, HAS_PRE = true; static constexpr int NST = 9;        static constexpr int SC_W = 0x7f7f7f7f, SC_X = 0x7f7f7f7f;
    bf16_t* YS; const float* row_w; unsigned char* dump;
    __device__ __forceinline__ void pre(int pm, unsigned ldsaddr, int wid) const {
        { const unsigned la = ldsaddr + (unsigned)(wid & 3) * 256u, vo = (unsigned)lane_now() * 4u; const float* gp = row_w + pm * BM + (wid & 3) * 64;
            const unsigned long g_ = (unsigned long)gp; const float* gs = (const float*)(((unsigned long)(unsigned)__builtin_amdgcn_readfirstlane((int)(g_ >> 32)) << 32) | (unsigned long)(unsigned)__builtin_amdgcn_readfirstlane((int)g_));
            asm volatile("s_mov_b32 m0, %0\n\ts_nop 0\n\tglobal_load_lds_dword %1, %2" :: "s"(la), "v"(vo), "s"(gs) : "memory", "m0"); }
    }
    __device__ __forceinline__ void operator()(const f32x4 (&acc)[2][2][4][2], const Unit& u, int wr, int wc, int fr, int fq, unsigned ldsaddr) const {
        const int cbase = u.aux2 & 0xFFFFF, valid = u.aux2 >> 20;
        const LAS float* rwp = (const LAS float*)(unsigned long)(ldsaddr + (unsigned)(wr * 64 + fr) * 4u); float w8[2][4];
#pragma unroll
        for (int ai = 0; ai < 2; ++ai)
#pragma unroll
            for (int m = 0; m < 4; ++m) w8[ai][m] = rwp[ai * HALF + m * 16];
        const int col0 = u.pn * BM + wc * 32 + 8 * (fq & ~1) + HALF * (fq & 1);
#pragma unroll
        for (int ai = 0; ai < 2; ++ai)
#pragma unroll
            for (int m = 0; m < 4; ++m) { const int r = ai * HALF + wr * 64 + m * 16 + fr; const float w_ = w8[ai][m] * (YS_SCALE * 0.001953125f);
                const f32x4 p0 = acc[ai][0][m][0] * w_, p1 = acc[ai][0][m][1] * w_, q0 = acc[ai][1][m][0] * w_, q1 = acc[ai][1][m][1] * w_;
                const auto sl = __builtin_amdgcn_permlane16_swap((unsigned)pk4_fp8(p0[0], p0[1], p0[2], p0[3]), (unsigned)pk4_fp8(q0[0], q0[1], q0[2], q0[3]), false, false);
                const auto sh = __builtin_amdgcn_permlane16_swap((unsigned)pk4_fp8(p1[0], p1[1], p1[2], p1[3]), (unsigned)pk4_fp8(q1[0], q1[1], q1[2], q1[3]), false, false);
                unsigned char* dst = (r < valid) ? (unsigned char*)YS + (size_t)(cbase + r) * D + col0 : dump + (col0 & 1023);
                *(u32x4*)dst = (u32x4){sl[0], sh[0], sl[1], sh[1]}; }
    }
};
struct EpiYsh {
    static constexpr int SC_W = 0x7f7f7f7f, SC_X = 0x7f7f7f7f;
    static constexpr bool PERM = true, HAS_MID = false, HAS_PRE = false; static constexpr int NST = 0;
    bf16_t* O;
    __device__ __forceinline__ void operator()(const f32x4 (&acc)[2][2][4][2], const Unit& u, int wr, int wc, int fr, int fq) const {
        const int row0 = u.pm * BM + wr * 64 + fr, col0 = u.pn * BM + wc * 32 + 8 * fq;
#pragma unroll
        for (int ai = 0; ai < 2; ++ai)
#pragma unroll
            for (int m = 0; m < 4; ++m) { bf16_t* rowp = O + (size_t)(row0 + ai * HALF + m * 16) * D + col0;
#pragma unroll
                for (int bj = 0; bj < 2; ++bj) { const f32x4 v0 = acc[ai][bj][m][0], v1 = acc[ai][bj][m][1];
                    u32x4 w; w.x = cvt_pk_bf16(v0[0], v0[1]); w.y = cvt_pk_bf16(v0[2], v0[3]); w.z = cvt_pk_bf16(v1[0], v1[1]); w.w = cvt_pk_bf16(v1[2], v1[3]);
                    *(u32x4*)(rowp + bj * HALF) = w; } }
    }
};
}

__device__ __forceinline__ void f_topk(const Params& P, int* lcnt, const int tid) {
    const float* LG = (const float*)(P.ws + WS_G); const float* rb = P.in[26];
    int* tok_e = (int*)(P.ws + WS_TOKE); float* tok_w = (float*)(P.ws + WS_TOKW); int* tok_lp = (int*)(P.ws + WS_TOKLP); int* blk_cnt = (int*)(P.ws + WS_BLKCNT);
    const int TPB = NTOK / gridDim.x, lane = tid & 63, wave = tid >> 6;
    for (int i = tid; i < NE; i += NT) lcnt[i] = 0;
    __syncthreads();
    float rbv[4], nx[4];
#pragma unroll
    for (int j = 0; j < 4; ++j) { rbv[j] = rb[lane + 64 * j]; nx[j] = LG[(size_t)(blockIdx.x * TPB + wave) * NE + lane + 64 * j]; }
    for (int tt = wave; tt < TPB; tt += NT / 64) {
        const int m = blockIdx.x * TPB + tt;
        float lgv[4];
#pragma unroll
        for (int j = 0; j < 4; ++j) lgv[j] = nx[j];
        if (tt + NT / 64 < TPB) {
#pragma unroll
            for (int j = 0; j < 4; ++j) nx[j] = LG[(size_t)(m + NT / 64) * NE + lane + 64 * j]; }
        float sc[4]; unsigned key[4];
#pragma unroll
        for (int j = 0; j < 4; ++j) { const int e = lane + 64 * j; sc[j] = sigmoidf_(lgv[j]); key[j] = (__float_as_uint(sc[j] + rbv[j] + 1.0f) & 0xFFFFFF00u) | (unsigned)(255 - e); }
        float wsum = 0.f; float myw = 0.f; int mye = 0;
#define DPP_MAXU(x, ctrl) x = max(x, (unsigned)__builtin_amdgcn_update_dpp(0, (int)(x), ctrl, 0xf, 0xf, true))
        for (int r = 0; r < TOPK; ++r) {
            unsigned k = max(max(key[0], key[1]), max(key[2], key[3]));
            DPP_MAXU(k, 0xB1); DPP_MAXU(k, 0x4E); DPP_MAXU(k, 0x141); DPP_MAXU(k, 0x140);
            { auto rr = __builtin_amdgcn_permlane16_swap(k, k, false, false); k = max(rr[0], rr[1]); }
            { auto rr = __builtin_amdgcn_permlane32_swap(k, k, false, false); k = max(rr[0], rr[1]); }
            const int idx = 255 - (int)(__builtin_amdgcn_readfirstlane(k) & 255u);
            const int owner = idx & 63, jsel = idx >> 6;
            const float sj = (jsel == 0) ? sc[0] : (jsel == 1) ? sc[1] : (jsel == 2) ? sc[2] : sc[3];
            const float s = __uint_as_float(__builtin_amdgcn_readlane(__float_as_uint(sj), owner));
#pragma unroll
            for (int j = 0; j < 4; ++j) if (lane == owner && j == jsel) key[j] = 0u;
            wsum += s;
            if (lane == r) { myw = s; mye = idx; }
        }
#undef DPP_MAXU
        if (lane < TOPK) {
            const int lp = __hip_atomic_fetch_add(&lcnt[mye], 1, __ATOMIC_RELAXED, __HIP_MEMORY_SCOPE_WORKGROUP);
            tok_e[m * TOPK + lane] = mye; tok_w[m * TOPK + lane] = myw / wsum * 2.5f; tok_lp[m * TOPK + lane] = lp;
        }
    }
    __syncthreads();
    for (int i = tid; i < NE; i += NT) blk_cnt[blockIdx.x * NE + i] = lcnt[i];
    __syncthreads();
}
__device__ __forceinline__ void f_route2(const Params& P, int* sm, const int tid) {
    const int* tok_e = (const int*)(P.ws + WS_TOKE); const float* tok_w = (const float*)(P.ws + WS_TOKW); const int* tok_lp = (const int*)(P.ws + WS_TOKLP); const int* blk_cnt = (const int*)(P.ws + WS_BLKCNT);
    int* tok_dest = (int*)(P.ws + WS_TOKDEST); int* row_tok = (int*)(P.ws + WS_ROWTOK); float* row_w = (float*)(P.ws + WS_ROWW);
    int* tile_e = (int*)(P.ws + WS_TILE); int* tile_cbase = tile_e + 2048; int* tile_valid = tile_e + 4096; int* ntiles = tile_e + 6144;
    int* s_tot = sm; int* s_base = sm + 256; int* s_ps = sm + 512; int* s_cs = sm + 768; int* s_misc = sm + 1024;
    const int G = gridDim.x, TPB = NTOK / G, lane = tid & 63;
    {
        typedef int i32x4_ __attribute__((ext_vector_type(4)));
        const int wv = tid >> 6; i32x4_ tot = {0, 0, 0, 0}, base = {0, 0, 0, 0};
#pragma unroll 8
        for (int b2 = wv; b2 < G; b2 += NT / 64) { const i32x4_ v = *(const i32x4_*)(blk_cnt + b2 * NE + 4 * lane); tot += v; if (b2 < (int)blockIdx.x) base += v; }
        int* part = sm - 16384;
#pragma unroll
        for (int j = 0; j < 4; ++j) { part[wv * 512 + 4 * lane + j] = tot[j]; part[wv * 512 + 256 + 4 * lane + j] = base[j]; }
        __syncthreads();
        { const int e = tid & 255, which = tid >> 8; int s = 0;
#pragma unroll
          for (int w2 = 0; w2 < NT / 64; ++w2) s += part[w2 * 512 + which * 256 + e];
          if (which == 0) s_tot[e] = s; else s_base[e] = s; }
    }
    __syncthreads();
    if (tid < 64) {
        int t[4], sp = 0, scs = 0;
#pragma unroll
        for (int j = 0; j < 4; ++j) { t[j] = s_tot[4 * lane + j]; sp += (t[j] + 255) & ~255; scs += t[j]; }
        int ip = sp, ic = scs;
#pragma unroll
        for (int o = 1; o < 64; o <<= 1) { const int a = __shfl_up(ip, o), b = __shfl_up(ic, o); if (lane >= o) { ip += a; ic += b; } }
        int ps = ip - sp, cs = ic - scs;
#pragma unroll
        for (int j = 0; j < 4; ++j) { s_ps[4 * lane + j] = ps; s_cs[4 * lane + j] = cs; ps += (t[j] + 255) & ~255; cs += t[j]; }
        if (lane == 63) s_misc[0] = ip;
    }
    __syncthreads();
    for (int pi = tid; pi < TPB * TOPK; pi += NT) {
        const int pair = blockIdx.x * TPB * TOPK + pi; const int e = tok_e[pair]; const int li = s_base[e] + tok_lp[pair];
        const int prow = s_ps[e] + li;
        tok_dest[pair] = s_cs[e] + li; row_tok[prow] = pair / TOPK; row_w[prow] = tok_w[pair];
    }
    for (int e = blockIdx.x; e < NE; e += G) {
        const int ps = s_ps[e], tot = s_tot[e], pad = (tot + 255) & ~255;
        for (int d = ps + tot + tid; d < ps + pad; d += NT) { row_tok[d] = 0; row_w[d] = 0.f; }
        for (int ti = ps / 256 + tid; ti < (ps + pad) / 256; ti += NT) { const int off = ti * 256 - ps; tile_e[ti] = e; tile_cbase[ti] = s_cs[e] + off; tile_valid[ti] = (tot - off) < 256 ? (tot - off) : 256; }
    }
    if (blockIdx.x == 0 && tid == 0) ntiles[0] = s_misc[0] / 256;
    __syncthreads();
}
__device__ __forceinline__ void f_final(const Params& P, const Ctx& c) {
    typedef float f32x2 __attribute__((ext_vector_type(2)));
    const unsigned char* YS = (const unsigned char*)(P.ws + WS_YS); const bf16_t* YSH = (const bf16_t*)(P.ws + WS_YSH); const int* tok_dest = (const int*)(P.ws + WS_TOKDEST);
    const float* mod = (const float*)(P.ws + WS_MOD); const float* g = P.in[33]; float* X = P.out;
    for (int m = c.gwave; m < NTOK; m += c.nwaves) {
        float tot[16];
#pragma unroll
        for (int i = 0; i < 16; ++i) tot[i] = 0.f;
        int dst[TOPK];
#pragma unroll
        for (int s = 0; s < TOPK; ++s) dst[s] = tok_dest[m * TOPK + s];
#pragma unroll
        for (int s = 0; s < TOPK; ++s) {
            const unsigned char* rp = YS + (size_t)dst[s] * D + 8 * c.lane;
#pragma unroll
            for (int j = 0; j < 2; ++j) { const u32x2 v = *(const u32x2*)(rp + 512 * j);
                const f32x2 a0 = __builtin_amdgcn_cvt_pk_f32_fp8((int)v[0], false), a1 = __builtin_amdgcn_cvt_pk_f32_fp8((int)v[0], true), a2 = __builtin_amdgcn_cvt_pk_f32_fp8((int)v[1], false), a3 = __builtin_amdgcn_cvt_pk_f32_fp8((int)v[1], true);
                tot[8 * j] += a0[0]; tot[8 * j + 1] += a0[1]; tot[8 * j + 2] += a1[0]; tot[8 * j + 3] += a1[1]; tot[8 * j + 4] += a2[0]; tot[8 * j + 5] += a2[1]; tot[8 * j + 6] += a3[0]; tot[8 * j + 7] += a3[1]; }
        }
        { const bf16_t* rp = YSH + (size_t)m * D + 8 * c.lane;
#pragma unroll
          for (int j = 0; j < 2; ++j) { const u32x4 v = *(const u32x4*)(rp + 512 * j);
#pragma unroll
              for (int e = 0; e < 8; ++e) tot[8 * j + e] = tot[8 * j + e] * (1.f / YS_SCALE) + pg8::bfe(v, e); } }
        const float* gt = mod + (size_t)(m / SEQ) * 6 * D + 5 * D; float* xr = X + (size_t)m * D; const bf16_t* x1r = (const bf16_t*)(P.ws + WS_X1) + (size_t)m * D; float ss = 0.f;
#pragma unroll
        for (int j = 0; j < 2; ++j)
#pragma unroll
            for (int hq = 0; hq < 2; ++hq) { const int col = 8 * c.lane + 512 * j + 4 * hq; const u32x2 xb_ = *(const u32x2*)(x1r + col); const f32x4 xv = (f32x4){pg8::bflo(xb_[0]), pg8::bfhi(xb_[0]), pg8::bflo(xb_[1]), pg8::bfhi(xb_[1])}, gv = *(const f32x4*)(gt + col);
#pragma unroll
                for (int q = 0; q < 4; ++q) { const float v = xv[q] + gv[q] * tot[8 * j + 4 * hq + q]; tot[8 * j + 4 * hq + q] = v; ss += v * v; } }
        ss = wave_sum(ss);
        const float rstd = rsqrtf(ss * (1.f / D) + 1e-6f);
#pragma unroll
        for (int j = 0; j < 2; ++j)
#pragma unroll
            for (int hq = 0; hq < 2; ++hq) { const int col = 8 * c.lane + 512 * j + 4 * hq; const f32x4 fg = *(const f32x4*)(g + col); f32x4 o;
#pragma unroll
                for (int q = 0; q < 4; ++q) o[q] = tot[8 * j + 4 * hq + q] * rstd * fg[q];
                *(f32x4*)(xr + col) = o; }
    }
}

#define XB_TMO      128
#define XB_XCNT(j)  (256  + 64 * (j))
#define XB_XSUB(j)  (1280 + 64 * (j))
#define XB_XGEN(j)  (2304 + 64 * (j))
#define XB_TOP      3328
#define XB_TOPGEN   3392
#define XCD_BAR_WORDS 3456
#define XB_SPIN_CAP (1u << 22)
__device__ __forceinline__ unsigned xb_ld(unsigned* p)              { return __hip_atomic_load(p, __ATOMIC_RELAXED, __HIP_MEMORY_SCOPE_AGENT); }
__device__ __forceinline__ unsigned xb_add(unsigned* p, unsigned v) { return __hip_atomic_fetch_add(p, v, __ATOMIC_RELAXED, __HIP_MEMORY_SCOPE_AGENT); }
__device__ __forceinline__ unsigned xb_xcc_id() { return (unsigned)__builtin_amdgcn_s_getreg((3 << 11) | 20) & 0xFu; }
#define XB_SPIN(cond, bar) do { unsigned _sp = 0; while (cond) { __builtin_amdgcn_s_sleep(1); \
    if ((++_sp & 255u) == 0u) { if (xb_ld(&(bar)[XB_TMO])) break; if (_sp > XB_SPIN_CAP) { atomicAdd(&(bar)[XB_TMO], 1u); break; } } } } while (0)
struct XcdBarrier { unsigned* bar; unsigned x; volatile LAS unsigned* st; };
__device__ __forceinline__ XcdBarrier xcd_barrier_post(unsigned* bar, volatile LAS unsigned* st, int tid) {
    XcdBarrier b; b.bar = bar; b.x = xb_xcc_id(); b.st = st;
    if (tid == 0) (void)xb_add(&bar[XB_XCNT(b.x)], 1u);
    return b;
}
__device__ __forceinline__ void xcd_barrier_complete(unsigned* bar, unsigned x, unsigned& nloc, unsigned& nx) {
    const unsigned G = gridDim.x * gridDim.y * gridDim.z;
    unsigned sum, cnt, mine, sp = 0u;
    for (;;) {
        sum = 0u; cnt = 0u; mine = 0u;
#pragma unroll
        for (unsigned j = 0; j < 16; ++j) { const unsigned c = xb_ld(&bar[XB_XCNT(j)]); sum += c; cnt += (c > 0u) ? 1u : 0u; mine = (j == x) ? c : mine; }
        if (sum == G) break;
        __builtin_amdgcn_s_sleep(1);
        if ((++sp & 255u) == 0u) { if (xb_ld(&bar[XB_TMO])) break; if (sp > XB_SPIN_CAP) { atomicAdd(&bar[XB_TMO], 1u); break; } }
    }
    nloc = mine > 0u ? mine : 1u; nx = cnt > 0u ? cnt : 1u;
}
__device__ __forceinline__ void xcd_barrier(const XcdBarrier& b, int tid) {
    asm volatile("s_waitcnt vmcnt(0)" ::: "memory");
    __syncthreads();
    if (tid == 0) {
        unsigned* bar = b.bar;
        __builtin_amdgcn_s_waitcnt(0);
        unsigned nloc = b.st[0], nx = b.st[1];
        if (nloc == 0u) { xcd_barrier_complete(bar, b.x, nloc, nx); b.st[0] = nloc; b.st[1] = nx; }
        const unsigned old = xb_add(&bar[XB_XSUB(b.x)], 1u);
        const unsigned gen = old / nloc;
        if (old + 1u == (gen + 1u) * nloc) {
            __builtin_amdgcn_fence(__ATOMIC_RELEASE, "agent");
            asm volatile("s_waitcnt vmcnt(0)" ::: "memory");
            const unsigned og = xb_add(&bar[XB_TOP], 1u);
            const unsigned tg = og / nx;
            if (og + 1u == (tg + 1u) * nx) xb_add(&bar[XB_TOPGEN], 1u);
            else XB_SPIN(xb_ld(&bar[XB_TOPGEN]) == tg, bar);
            __builtin_amdgcn_fence(__ATOMIC_ACQUIRE, "agent");
            xb_add(&bar[XB_XGEN(b.x)], 1u);
            asm volatile("s_waitcnt vmcnt(0)" ::: "memory");
        } else {
            XB_SPIN(xb_ld(&bar[XB_XGEN(b.x)]) == gen, bar);
            __builtin_amdgcn_fence(__ATOMIC_ACQUIRE, "agent");
            asm volatile("s_waitcnt vmcnt(0)" ::: "memory");
        }
    }
    __syncthreads();
}

#define DPP_ADD(x, ctrl) x += __uint_as_float(__builtin_amdgcn_update_dpp(0, __float_as_uint(x), ctrl, 0xf, 0xf, true))
__device__ __forceinline__ float red32(float x) {
    DPP_ADD(x, 0xB1); DPP_ADD(x, 0x4E); DPP_ADD(x, 0x141); DPP_ADD(x, 0x140);
    auto rr = __builtin_amdgcn_permlane16_swap(__float_as_uint(x), __float_as_uint(x), false, false);
    return __uint_as_float(rr[0]) + __uint_as_float(rr[1]);
}
__device__ __forceinline__ float fma_s(float a, float b, float c) { float r; asm("v_fma_f32 %0, %1, %2, %3" : "=v"(r) : "v"(a), "v"(b), "v"(c)); return r; }
__device__ __forceinline__ float mul_s(float a, float b) { float r; asm("v_mul_f32_e32 %0, %1, %2" : "=v"(r) : "v"(a), "v"(b)); return r; }
__device__ __forceinline__ float add_s(float a, float b) { float r; asm("v_add_f32_e32 %0, %1, %2" : "=v"(r) : "v"(a), "v"(b)); return r; }
__device__ __forceinline__ void f_scan(const Params& P, LAS unsigned char* lds, int tid) {
    constexpr int NCHK = SEQ / 16, SLOT = 16384, RD = 8, AHEAD = 7, PPL = 4;
    static_assert(RD * SLOT <= LDS_BYTES, "scan ring");
    const int lane = tid & 63, w = __builtin_amdgcn_readfirstlane(tid >> 6), c16 = lane & 15, g = lane >> 4;
    const int bh = blockIdx.x;
    if (bh >= NB * 8) return;
    const int b = bh >> 3, h = bh & 7;
    const unsigned char* ops = ops_ptr(P, bh);
    const bf16_t* SVb = (const bf16_t*)(P.ws + WS_SCANV) + (size_t)b * SEQ * CW + h * 64;
    if (w >= 4) {
        const int hw = w - 4;
        const unsigned lo_op = (unsigned)lane * 16u, lo_v = (unsigned)((lane >> 3) * CW + (lane & 7) * 8) * 2u;
#define SC_ISSUE(ch_) do { unsigned cc_ = (unsigned)(ch_); asm volatile("" : "+s"(cc_)); const unsigned so_ = (cc_ & (RD - 1)) * SLOT; \
            _Pragma("unroll") for (int n_ = 0; n_ < PPL; ++n_) { const int p_ = hw * PPL + n_; \
                if (p_ < 13) __builtin_amdgcn_global_load_lds((const unsigned*)(ops + (size_t)cc_ * OPB + p_ * 1024 + lo_op), (LAS unsigned*)(lds + so_ + p_ * 1024), 16, 0, 0); \
                else if (p_ < 15) __builtin_amdgcn_global_load_lds((const unsigned*)((const char*)(SVb + (size_t)(cc_ * 16 + (p_ - 13) * 8) * CW) + lo_v), (LAS unsigned*)(lds + so_ + 13312 + (p_ - 13) * 1024), 16, 0, 0); \
                else __builtin_amdgcn_global_load_lds((const unsigned*)(ops + (size_t)cc_ * OPB + lo_op), (LAS unsigned*)(lds + so_ + 15360), 16, 0, 0); } } while (0)
        for (int c0 = 0; c0 < AHEAD; ++c0) SC_ISSUE(c0);
        for (int ch = 0; ch < NCHK; ++ch) {
            if (ch + AHEAD - 1 < NCHK) asm volatile("s_waitcnt vmcnt(20)" ::: "memory");
            else asm volatile("s_waitcnt vmcnt(0)" ::: "memory");
            __builtin_amdgcn_s_barrier();
            if (ch + AHEAD < NCHK) SC_ISSUE(ch + AHEAD);
        }
#undef SC_ISSUE
    } else {
        const int rho0 = 16 * w;
        bf16_t* Y = (bf16_t*)(P.ws + WS_Y) + (size_t)b * SEQ * CW + h * 64 + rho0 + c16 + (size_t)(4 * g) * CW;
        f32x4 D0 = (f32x4){0.f, 0.f, 0.f, 0.f}, D1 = D0, D2 = D0, D3 = D0;
        u32x4 gf[8], rf[2]; u32x2 hf[4], mf; bf16_t vv[4];
#define SC_RD(ch_, GF, RF, HF, MF, VV) do { const LAS unsigned char* sl_ = lds + ((ch_) & (RD - 1)) * SLOT; \
            _Pragma("unroll") for (int i_ = 0; i_ < 8; ++i_) GF[i_] = *(const LAS u32x4*)(sl_ + i_ * 1024 + lane * 16); \
            RF[0] = *(const LAS u32x4*)(sl_ + 8192 + lane * 16); RF[1] = *(const LAS u32x4*)(sl_ + 9216 + lane * 16); \
            _Pragma("unroll") for (int i_ = 0; i_ < 4; ++i_) HF[i_] = *(const LAS u32x2*)(sl_ + 10240 + i_ * 512 + lane * 8); \
            MF = *(const LAS u32x2*)(sl_ + 12288 + lane * 8); \
            _Pragma("unroll") for (int e_ = 0; e_ < 4; ++e_) VV[e_] = *(const LAS bf16_t*)(sl_ + 13312 + (4 * g + e_) * 128 + (rho0 + c16) * 2); } while (0)
        for (int ch = 0; ch < NCHK; ++ch) {
            __builtin_amdgcn_s_barrier();
            asm volatile("" ::: "memory");
            if (ch == 0) SC_RD(0, gf, rf, hf, mf, vv);
            u32x4 ngf[8], nrf[2]; u32x2 nhf[4], nmf; bf16_t nvv[4];
            { const int chn = (ch + 1 < NCHK) ? ch + 1 : ch; SC_RD(chn, ngf, nrf, nhf, nmf, nvv); }
            __builtin_amdgcn_sched_barrier(0);
            u32x4 bs0, bs1, bv;
            bs0.x = pg8::cvt_pk_bf16(D0[0], D0[1]); bs0.y = pg8::cvt_pk_bf16(D0[2], D0[3]); bs0.z = pg8::cvt_pk_bf16(D1[0], D1[1]); bs0.w = pg8::cvt_pk_bf16(D1[2], D1[3]);
            bs1.x = pg8::cvt_pk_bf16(D2[0], D2[1]); bs1.y = pg8::cvt_pk_bf16(D2[2], D2[3]); bs1.z = pg8::cvt_pk_bf16(D3[0], D3[1]); bs1.w = pg8::cvt_pk_bf16(D3[2], D3[3]);
            bv.x = (unsigned)vv[0] | ((unsigned)vv[1] << 16); bv.y = (unsigned)vv[2] | ((unsigned)vv[3] << 16); bv.z = 0u; bv.w = 0u;
            const bf16x8 B0 = __builtin_bit_cast(bf16x8, bs0), B1 = __builtin_bit_cast(bf16x8, bs1), BV = __builtin_bit_cast(bf16x8, bv);
            const f32x4 z4 = (f32x4){0.f, 0.f, 0.f, 0.f};
#define SC_TILE(mt_) ({ f32x4 n_ = __builtin_amdgcn_mfma_f32_16x16x32_bf16(__builtin_bit_cast(bf16x8, gf[2 * (mt_)]), B0, z4, 0, 0, 0); \
                n_ = __builtin_amdgcn_mfma_f32_16x16x32_bf16(__builtin_bit_cast(bf16x8, gf[2 * (mt_) + 1]), B1, n_, 0, 0, 0); \
                const u32x4 h_ = (u32x4){hf[mt_][0], hf[mt_][1], 0u, 0u}; \
                __builtin_amdgcn_mfma_f32_16x16x32_bf16(__builtin_bit_cast(bf16x8, h_), BV, n_, 0, 0, 0); })
            const f32x4 n0 = SC_TILE(0), n1 = SC_TILE(1), n2 = SC_TILE(2), n3 = SC_TILE(3);
            f32x4 yt = __builtin_amdgcn_mfma_f32_16x16x32_bf16(__builtin_bit_cast(bf16x8, rf[0]), B0, z4, 0, 0, 0);
            yt = __builtin_amdgcn_mfma_f32_16x16x32_bf16(__builtin_bit_cast(bf16x8, rf[1]), B1, yt, 0, 0, 0);
            { const u32x4 m_ = (u32x4){mf[0], mf[1], 0u, 0u}; yt = __builtin_amdgcn_mfma_f32_16x16x32_bf16(__builtin_bit_cast(bf16x8, m_), BV, yt, 0, 0, 0); }
            D0 = n0; D1 = n1; D2 = n2; D3 = n3;
#pragma unroll
            for (int r_ = 0; r_ < 4; ++r_) Y[(size_t)(ch * 16 + r_) * CW] = f2bf(yt[r_]);
#pragma unroll
            for (int i_ = 0; i_ < 8; ++i_) gf[i_] = ngf[i_];
            rf[0] = nrf[0]; rf[1] = nrf[1];
#pragma unroll
            for (int i_ = 0; i_ < 4; ++i_) { hf[i_] = nhf[i_]; vv[i_] = nvv[i_]; }
            mf = nmf;
            asm volatile("s_waitcnt lgkmcnt(0)" ::: "memory");
#undef SC_TILE
        }
#undef SC_RD
    }
}

__device__ __forceinline__ void f_mod(const Params& P, LAS unsigned char* lds, int tid) {
    const float* cc = P.in[1]; const float* w = P.in[2]; const float* bias = P.in[3];
    float* mod = (float*)(P.ws + WS_MOD);
    LAS float* sc = (LAS float*)lds;
    LAS float* red = (LAS float*)(lds + 32768);
    const int lane = tid & 63, wv = __builtin_amdgcn_readfirstlane(tid >> 6);
    for (int item = blockIdx.x; item < 96; item += gridDim.x) {
        for (int i = tid; i < NB * D; i += NT) sc[i] = siluf_(cc[i]);
        __syncthreads();
        const int col = item * 64 + lane;
        float acc[NB];
#pragma unroll
        for (int i = 0; i < NB; ++i) acc[i] = 0.f;
#pragma unroll 16
        for (int k = wv * 128; k < wv * 128 + 128; ++k) {
            const float x = w[(size_t)k * 6 * D + col];
#pragma unroll
            for (int i = 0; i < NB; ++i) acc[i] += sc[i * D + k] * x;
        }
#pragma unroll
        for (int i = 0; i < NB; ++i) red[(wv * NB + i) * 64 + lane] = acc[i];
        __syncthreads();
        { const int i = tid >> 6; float s = 0.f;
#pragma unroll
          for (int w2 = 0; w2 < 8; ++w2) s += red[(w2 * NB + i) * 64 + lane];
          mod[i * 6 * D + col] = s + bias[col]; }
        __syncthreads();
    }
}

#define DPP_ADDF(x, ctrl) x += __uint_as_float(__builtin_amdgcn_update_dpp(0, __float_as_uint(x), ctrl, 0xf, 0xf, true))
__device__ __forceinline__ float red16(float x) { DPP_ADDF(x, 0xB1); DPP_ADDF(x, 0x4E); DPP_ADDF(x, 0x141); DPP_ADDF(x, 0x140); return x; }
__device__ __forceinline__ float red64(float x) {
    x = red16(x);
    { auto rr = __builtin_amdgcn_permlane16_swap(__float_as_uint(x), __float_as_uint(x), false, false); x = __uint_as_float(rr[0]) + __uint_as_float(rr[1]); }
    { auto rr = __builtin_amdgcn_permlane32_swap(__float_as_uint(x), __float_as_uint(x), false, false); x = __uint_as_float(rr[0]) + __uint_as_float(rr[1]); }
    return x;
}
__device__ __forceinline__ float fast_tanh(float x) { const float t = __expf(2.f * x); return 1.f - 2.f * __builtin_amdgcn_rcpf(t + 1.f); }
__device__ __forceinline__ float fast_sig(float x) { return __builtin_amdgcn_rcpf(1.f + __expf(-x)); }
__device__ __forceinline__ float fast_gelu(float x) { return 0.5f * x * (1.f + fast_tanh(0.7978845608028654f * (x + 0.044715f * x * x * x))); }

__device__ __forceinline__ void f_prep_gmlp(const Params& P, LAS unsigned char* lds, int tid) {
    typedef float f32x2 __attribute__((ext_vector_type(2)));
    const bf16_t* Pp = (const bf16_t*)(P.ws + WS_P);
    const float *mu = P.in[6], *w0 = P.in[7], *a0 = P.in[9], *k_k = P.in[12], *k_a = P.in[13], *r_k = P.in[14];
    const float *lng = P.in[17], *lnb = P.in[18], *wsp = P.in[19], *bsp = P.in[20];
    const bf16_t* w2t = (const bf16_t*)(P.ws + WS_LORA); const bf16_t* a2t = w2t + 512 * 64; const bf16_t* g2t = a2t + 512 * 64;
    bf16_t* SV = (bf16_t*)(P.ws + WS_SCANV);
    float* Gb = (float*)(P.ws + WS_G); float* bonus = (float*)(P.ws + WS_BONUS);
    bf16_t* O = (bf16_t*)(P.ws + WS_O);
    const int lane = tid & 63, w = __builtin_amdgcn_readfirstlane(tid >> 6), c16 = lane & 15, q4 = lane >> 4;
    constexpr int AST = 528;
    constexpr int VST = 272, VWAVE = 64 * VST;
    if (blockIdx.x < NTOK / 128) {
        const int unit = blockIdx.x; const int m0 = unit * 128;
        constexpr int ATILE = 16 * AST, CONST_OFF = 2 * ATILE, SCR0 = CONST_OFF + 16384, SCRW = 15104;
        constexpr int XS = 144;
        constexpr int O_XA = 0, O_XR = 2304, O_XB = 4608, O_XK = 6912, O_BN = 9216, O_BP = 10304, O_BQ = 11392, O_AT = 12480, O_ECL = 14784;
        static_assert(O_AT + 64 * 32 <= O_ECL && O_ECL + 256 <= SCRW && SCR0 + 8 * SCRW <= LDS_BYTES, "prep LDS map");
        {
            LAS float* cf = (LAS float*)(lds + CONST_OFF);
            const int cidx = tid;
            cf[cidx] = mu[cidx]; cf[512 + cidx] = mu[512 + cidx]; cf[1024 + cidx] = mu[1024 + cidx]; cf[1536 + cidx] = w0[cidx]; cf[2048 + cidx] = a0[cidx]; cf[2560 + cidx] = k_k[cidx]; cf[3072 + cidx] = k_a[cidx]; cf[3584 + cidx] = r_k[cidx];
        }
        const int a_row = tid >> 5, a_l32 = tid & 31, a_col8 = 8 * a_l32;
        float mu8[8];
#pragma unroll
        for (int e = 0; e < 8; ++e) mu8[e] = mu[1536 + a_col8 + e];
#define PREP_ATILE(mt_, buf_) do { const int m_ = m0 + 16 * (mt_) + a_row; \
            const u32x4 pc_ = *(const u32x4*)(Pp + (size_t)m_ * INC + 1536 + a_col8); u32x4 pp_ = (u32x4){0u, 0u, 0u, 0u}; \
            if (m_ % SEQ) pp_ = *(const u32x4*)(Pp + (size_t)(m_ - 1) * INC + 1536 + a_col8); \
            float v_[8]; \
            _Pragma("unroll") for (int e = 0; e < 8; ++e) { const float x_ = pg8::bfe(pc_, e), xp_ = pg8::bfe(pp_, e); const float xs_ = x_ + (xp_ - x_) * mu8[e]; \
                v_[e] = (a_l32 < 8) ? fast_tanh(xs_) : ((a_l32 < 16) ? xs_ : fast_sig(xs_)); } \
            u32x4 o_; o_.x = pg8::cvt_pk_bf16(v_[0], v_[1]); o_.y = pg8::cvt_pk_bf16(v_[2], v_[3]); o_.z = pg8::cvt_pk_bf16(v_[4], v_[5]); o_.w = pg8::cvt_pk_bf16(v_[6], v_[7]); \
            *(LAS u32x4*)(lds + (buf_) * ATILE + a_row * AST + a_col8 * 2) = o_; } while (0)
        PREP_ATILE(0, 0);
        __syncthreads();
        {
            const int colb = 64 * w + 4 * c16;
            const LAS f32x4* cst = (const LAS f32x4*)(lds + CONST_OFF) + (colb >> 2);
            const char* P8 = (const char*)Pp;
            LAS unsigned char* scr = lds + SCR0 + w * SCRW;
            const int bh = (m0 / SEQ) * 8 + w;
            unsigned char* opsb = ops_ptr(P, bh) + (size_t)((m0 % SEQ) / 16) * OPB;
#define PREP_LOAD(rr_, CR, CK, CV, QR, QK, QV) do { const int m_ = m0 + 16 * mt + 4 * q4 + (rr_); const unsigned pb_ = (unsigned)(m_ * INC + colb) * 2u; \
                CR = *(const uint2*)(P8 + pb_); CK = *(const uint2*)(P8 + pb_ + 1024u); CV = *(const uint2*)(P8 + pb_ + 2048u); QR = make_uint2(0u, 0u); QK = QR; QV = QR; \
                if (m_ % SEQ) { const unsigned qb_ = pb_ - (unsigned)(INC * 2); QR = *(const uint2*)(P8 + qb_); QK = *(const uint2*)(P8 + qb_ + 1024u); QV = *(const uint2*)(P8 + qb_ + 2048u); } } while (0)
            for (int mt = 0; mt < 8; ++mt) {
                if (mt + 1 < 8) PREP_ATILE(mt + 1, (mt + 1) & 1);
                uint2 cr, ck, cv, qr, qk, qv, ncr, nck, ncv, nqr, nqk, nqv;
                PREP_LOAD(0, cr, ck, cv, qr, qk, qv);
                f32x4 aw[4], aa[4], ag[4];
#pragma unroll
                for (int j = 0; j < 4; ++j) { aw[j] = (f32x4){0.f, 0.f, 0.f, 0.f}; aa[j] = aw[j]; ag[j] = aw[j]; }
                const LAS unsigned char* arow = lds + (mt & 1) * ATILE + c16 * AST + 16 * q4;
#pragma unroll
                for (int ks = 0; ks < 2; ++ks) {
                    const bf16x8 fw = *(const LAS bf16x8*)(arow + ks * 64), fa = *(const LAS bf16x8*)(arow + 128 + ks * 64);
#pragma unroll
                    for (int j = 0; j < 4; ++j) {
                        const bf16x8 bw = *(const bf16x8*)(w2t + (size_t)(colb + j) * 64 + ks * 32 + 8 * q4), ba = *(const bf16x8*)(a2t + (size_t)(colb + j) * 64 + ks * 32 + 8 * q4);
                        aw[j] = __builtin_amdgcn_mfma_f32_16x16x32_bf16(fw, bw, aw[j], 0, 0, 0);
                        aa[j] = __builtin_amdgcn_mfma_f32_16x16x32_bf16(fa, ba, aa[j], 0, 0, 0);
                    }
                }
#pragma unroll
                for (int ks = 0; ks < 4; ++ks) {
                    const bf16x8 fg = *(const LAS bf16x8*)(arow + 256 + ks * 64);
#pragma unroll
                    for (int j = 0; j < 4; ++j) { const bf16x8 bg = *(const bf16x8*)(g2t + (size_t)(colb + j) * 128 + ks * 32 + 8 * q4); ag[j] = __builtin_amdgcn_mfma_f32_16x16x32_bf16(fg, bg, ag[j], 0, 0, 0); }
                }
                float ta[4][4], tb[4][4], tk[4][4], tr[4][4], tl[4][4];
#pragma unroll
                for (int rr = 0; rr < 4; ++rr) {
                    const int m = m0 + 16 * mt + 4 * q4 + rr;
                    if (rr < 3) PREP_LOAD(rr + 1, ncr, nck, ncv, nqr, nqk, nqv);
                    const f32x4 mur = cst[0], muk = cst[128], muv = cst[256], w0v = cst[384], a0v = cst[512], kkv = cst[640], kav = cst[768], rkv = cst[896];
                    float v4[4], an[4], bn4[4];
                    float ss = 0.f, bsum = 0.f;
#pragma unroll
                    for (int j = 0; j < 4; ++j) {
                        const unsigned wr_ = (j < 2) ? cr.x : cr.y, wk_ = (j < 2) ? ck.x : ck.y, wv_ = (j < 2) ? cv.x : cv.y, pr_ = (j < 2) ? qr.x : qr.y, pk_ = (j < 2) ? qk.x : qk.y, pv_ = (j < 2) ? qv.x : qv.y;
                        const float xr = (j & 1) ? pg8::bfhi(wr_) : pg8::bflo(wr_), xk = (j & 1) ? pg8::bfhi(wk_) : pg8::bflo(wk_), xv = (j & 1) ? pg8::bfhi(wv_) : pg8::bflo(wv_);
                        const float yr = (j & 1) ? pg8::bfhi(pr_) : pg8::bflo(pr_), yk = (j & 1) ? pg8::bfhi(pk_) : pg8::bflo(pk_), yv = (j & 1) ? pg8::bfhi(pv_) : pg8::bflo(pv_);
                        const float r1 = xr + (yr - xr) * mur[j], k1 = xk + (yk - xk) * muk[j]; v4[j] = xv + (yv - xv) * muv[j];
                        const float z = -(w0v[j] + aw[j][rr]);
                        const float sp = fmaxf(z, 0.f) + __logf(1.f + __expf(-fabsf(z)));
                        tl[rr][j] = -__expf(-sp - 0.5f);
                        const float a = fast_sig(a0v[j] + aa[j][rr]);
                        const float kk = k1 * kkv[j];
                        ss += kk * kk;
                        tk[rr][j] = k1 * (1.f + (a - 1.f) * kav[j]);
                        tr[rr][j] = r1;
                        bsum += r1 * tk[rr][j] * rkv[j];
                        an[j] = kk; bn4[j] = a;
                    }
                    ss = red16(ss); bsum = red16(bsum);
                    const float rn = rsqrtf(fmaxf(ss, 1e-24f));
                    const unsigned ob = (unsigned)(m * CW + colb) * 4u;
                    f32x4 oV, oG;
#pragma unroll
                    for (int j = 0; j < 4; ++j) { const float kkn = an[j] * rn; ta[rr][j] = -kkn; tb[rr][j] = kkn * bn4[j]; oV[j] = v4[j]; oG[j] = ag[j][rr]; }
                    *(u32x2*)((char*)SV + (ob >> 1)) = (u32x2){pg8::cvt_pk_bf16(oV[0], oV[1]), pg8::cvt_pk_bf16(oV[2], oV[3])}; *(u32x2*)((char*)Gb + (ob >> 1)) = (u32x2){pg8::cvt_pk_bf16(oG[0], oG[1]), pg8::cvt_pk_bf16(oG[2], oG[3])};
                    if (c16 == 0) bonus[m * 8 + w] = bsum;
                    cr = ncr; ck = nck; cv = ncv; qr = nqr; qk = nqk; qv = nqv;
                }
                float cinc[4][4], cL[4];
#pragma unroll
                for (int j = 0; j < 4; ++j) {
                    float run = 0.f;
#pragma unroll
                    for (int rr = 0; rr < 4; ++rr) { run += tl[rr][j]; cinc[rr][j] = run; }
                    const float t1 = __shfl(run, (lane - 16) & 63), t2 = __shfl(run, (lane - 32) & 63), t3 = __shfl(run, (lane - 48) & 63);
                    const float off = (q4 >= 1 ? t1 : 0.f) + (q4 >= 2 ? t2 : 0.f) + (q4 >= 3 ? t3 : 0.f);
#pragma unroll
                    for (int rr = 0; rr < 4; ++rr) cinc[rr][j] += off;
                    cL[j] = __shfl(cinc[3][j], 48 + c16);
                }
#pragma unroll
                for (int rr = 0; rr < 4; ++rr) {
                    float xa[4], xr_[4], xb[4], xk[4];
#pragma unroll
                    for (int j = 0; j < 4; ++j) { const float ec = __expf(cinc[rr][j]), ecx = __expf(cinc[rr][j] - tl[rr][j]), en = __expf(-cinc[rr][j]);
                        xa[j] = ta[rr][j] * ecx; xr_[j] = tr[rr][j] * ec; xb[j] = tb[rr][j] * en; xk[j] = tk[rr][j] * en; }
                    LAS unsigned char* xp = scr + (4 * q4 + rr) * XS + c16 * 8;
                    *(LAS u32x2*)(xp + O_XA) = (u32x2){pg8::cvt_pk_bf16(xa[0], xa[1]), pg8::cvt_pk_bf16(xa[2], xa[3])};
                    *(LAS u32x2*)(xp + O_XR) = (u32x2){pg8::cvt_pk_bf16(xr_[0], xr_[1]), pg8::cvt_pk_bf16(xr_[2], xr_[3])};
                    *(LAS u32x2*)(xp + O_XB) = (u32x2){pg8::cvt_pk_bf16(xb[0], xb[1]), pg8::cvt_pk_bf16(xb[2], xb[3])};
                    *(LAS u32x2*)(xp + O_XK) = (u32x2){pg8::cvt_pk_bf16(xk[0], xk[1]), pg8::cvt_pk_bf16(xk[2], xk[3])};
                }
                if (q4 == 0) *(LAS f32x4*)(scr + O_ECL + c16 * 16) = (f32x4){__expf(cL[0]), __expf(cL[1]), __expf(cL[2]), __expf(cL[3])};
                asm volatile("s_waitcnt lgkmcnt(0)" ::: "memory");
#define SM_WR(off_, v_) do { _Pragma("unroll") for (int r_ = 0; r_ < 4; ++r_) *(LAS float*)(scr + (off_) + ((4 * q4 + r_) * 17 + c16) * 4) = (v_)[r_]; } while (0)
#define SM_A(off_, kk_) (*(const LAS float*)(scr + (off_) + (c16 * 17 + 4 * (kk_) + q4) * 4))
#define SM_B(off_, kk_) (*(const LAS float*)(scr + (off_) + ((4 * (kk_) + q4) * 17 + c16) * 4))
#define XV(off_, tok_, col_) bf2f(*(const LAS bf16_t*)(scr + (off_) + (tok_) * XS + (col_) * 2))
                f32x4 mN = (f32x4){0.f, 0.f, 0.f, 0.f}, mK = mN, mQb = mN, mQk = mN;
                {
                    const LAS unsigned char* rowp = scr + c16 * XS + 16 * q4;
#pragma unroll
                    for (int ks = 0; ks < 2; ++ks) {
                        const bf16x8 fa = *(const LAS bf16x8*)(rowp + O_XA + 64 * ks), fr = *(const LAS bf16x8*)(rowp + O_XR + 64 * ks), fb = *(const LAS bf16x8*)(rowp + O_XB + 64 * ks), fk = *(const LAS bf16x8*)(rowp + O_XK + 64 * ks);
                        mN = __builtin_amdgcn_mfma_f32_16x16x32_bf16(fb, fa, mN, 0, 0, 0); mK = __builtin_amdgcn_mfma_f32_16x16x32_bf16(fk, fa, mK, 0, 0, 0);
                        mQb = __builtin_amdgcn_mfma_f32_16x16x32_bf16(fb, fr, mQb, 0, 0, 0); mQk = __builtin_amdgcn_mfma_f32_16x16x32_bf16(fk, fr, mQk, 0, 0, 0);
                    }
#pragma unroll
                    for (int r_ = 0; r_ < 4; ++r_) { const int s_ = 4 * q4 + r_; if (!(s_ < c16)) { mN[r_] = 0.f; mK[r_] = 0.f; } if (!(s_ <= c16)) { mQb[r_] = 0.f; mQk[r_] = 0.f; } }
                }
#define SM_MUL(dst_, offA_, idA_, offB_, idB_) do { dst_ = (f32x4){0.f, 0.f, 0.f, 0.f}; _Pragma("unroll") for (int kk_ = 0; kk_ < 4; ++kk_) { \
                        float a_ = SM_A(offA_, kk_), b_ = SM_B(offB_, kk_); if ((idA_) && c16 == 4 * kk_ + q4) a_ += 1.f; if ((idB_) && c16 == 4 * kk_ + q4) b_ += 1.f; \
                        dst_ = __builtin_amdgcn_mfma_f32_16x16x4f32(a_, b_, dst_, 0, 0, 0); } } while (0)
#define LFENCE() asm volatile("s_waitcnt lgkmcnt(0)" ::: "memory")
                f32x4 t0, t1v, t2v;
                SM_WR(O_BN, mN); LFENCE();
                SM_MUL(t0, O_BN, false, O_BN, false);
                SM_WR(O_BP, t0); LFENCE();
                SM_MUL(t1v, O_BN, true, O_BP, true);
                SM_MUL(t2v, O_BP, false, O_BP, false);
                LFENCE(); SM_WR(O_BN, t2v); SM_WR(O_BQ, t1v); LFENCE();
                SM_MUL(t0, O_BN, false, O_BN, false);
                SM_MUL(t1v, O_BQ, false, O_BN, true);
                LFENCE(); SM_WR(O_BP, t0); SM_WR(O_BQ, t1v); LFENCE();
                SM_MUL(t2v, O_BQ, false, O_BP, true);
                LFENCE(); SM_WR(O_BN, t2v); SM_WR(O_BP, mK); LFENCE();
                {
                    f32x4 at[4];
#pragma unroll
                    for (int mt2 = 0; mt2 < 4; ++mt2) { at[mt2] = (f32x4){0.f, 0.f, 0.f, 0.f};
#pragma unroll
                        for (int kk = 0; kk < 4; ++kk) at[mt2] = __builtin_amdgcn_mfma_f32_16x16x4f32(XV(O_XA, 4 * kk + q4, 16 * mt2 + c16), SM_B(O_BN, kk), at[mt2], 0, 0, 0); }
                    SM_MUL(t0, O_BP, false, O_BN, false);
#pragma unroll
                    for (int mt2 = 0; mt2 < 4; ++mt2)
#pragma unroll
                        for (int r_ = 0; r_ < 4; ++r_) *(LAS bf16_t*)(scr + O_AT + (16 * mt2 + 4 * q4 + r_) * 32 + c16 * 2) = f2bf(at[mt2][r_]);
                    LFENCE(); SM_WR(O_BQ, t0); SM_WR(O_BP, mQb); LFENCE();
                }
#define AT_A(j_, kk_) bf2f(*(const LAS bf16_t*)(scr + O_AT + (j_) * 32 + (4 * (kk_) + q4) * 2))
                {
                    f32x4 ry[4];
#pragma unroll
                    for (int mt2 = 0; mt2 < 4; ++mt2) { ry[mt2] = (f32x4){0.f, 0.f, 0.f, 0.f};
#pragma unroll
                        for (int kk = 0; kk < 4; ++kk) ry[mt2] = __builtin_amdgcn_mfma_f32_16x16x4f32(AT_A(16 * mt2 + c16, kk), SM_B(O_BP, kk), ry[mt2], 0, 0, 0);
#pragma unroll
                        for (int r_ = 0; r_ < 4; ++r_) ry[mt2][r_] += XV(O_XR, c16, 16 * mt2 + 4 * q4 + r_); }
                    SM_MUL(t0, O_BQ, false, O_BP, false);
#pragma unroll
                    for (int r_ = 0; r_ < 4; ++r_) t0[r_] += mQk[r_];
#pragma unroll
                    for (int s2 = 0; s2 < 2; ++s2) { u32x4 o; o.x = pg8::cvt_pk_bf16(ry[2 * s2][0], ry[2 * s2][1]); o.y = pg8::cvt_pk_bf16(ry[2 * s2][2], ry[2 * s2][3]); o.z = pg8::cvt_pk_bf16(ry[2 * s2 + 1][0], ry[2 * s2 + 1][1]); o.w = pg8::cvt_pk_bf16(ry[2 * s2 + 1][2], ry[2 * s2 + 1][3]);
                        *(u32x4*)(opsb + (size_t)mt * OPB + 8192 + s2 * 1024 + lane * 16) = o; }
                    *(uint2*)(opsb + (size_t)mt * OPB + 12288 + lane * 8) = make_uint2(pg8::cvt_pk_bf16(t0[0], t0[1]), pg8::cvt_pk_bf16(t0[2], t0[3]));
                }
                {
                    u32x2 own[4];
#pragma unroll
                    for (int rr = 0; rr < 4; ++rr) own[rr] = *(const LAS u32x2*)(scr + O_XB + (4 * q4 + rr) * XS + c16 * 8);
                    LFENCE();
#pragma unroll
                    for (int j = 0; j < 4; ++j) { const unsigned w0_ = own[0][j >> 1], w1_ = own[1][j >> 1], w2_ = own[2][j >> 1], w3_ = own[3][j >> 1];
                        const unsigned e0 = (j & 1) ? (w0_ >> 16) : (w0_ & 0xffffu), e1 = (j & 1) ? (w1_ >> 16) : (w1_ & 0xffffu), e2 = (j & 1) ? (w2_ >> 16) : (w2_ & 0xffffu), e3 = (j & 1) ? (w3_ >> 16) : (w3_ & 0xffffu);
                        *(LAS u32x2*)(scr + O_XB + (4 * c16 + j) * 32 + q4 * 8) = (u32x2){e0 | (e1 << 16), e2 | (e3 << 16)}; }
                    LFENCE();
                    const bf16x8 zf = (bf16x8){0, 0, 0, 0, 0, 0, 0, 0};
                    bf16x8 fat[4], fmt = zf;
#pragma unroll
                    for (int mt2 = 0; mt2 < 4; ++mt2) fat[mt2] = (q4 < 2) ? *(const LAS bf16x8*)(scr + O_AT + (16 * mt2 + c16) * 32 + 16 * q4) : zf;
                    if (q4 < 2) { float mv[8];
#pragma unroll
                        for (int e = 0; e < 8; ++e) mv[e] = *(const LAS float*)(scr + O_BQ + (c16 * 17 + 8 * q4 + e) * 4);
                        u32x4 mu_; mu_.x = pg8::cvt_pk_bf16(mv[0], mv[1]); mu_.y = pg8::cvt_pk_bf16(mv[2], mv[3]); mu_.z = pg8::cvt_pk_bf16(mv[4], mv[5]); mu_.w = pg8::cvt_pk_bf16(mv[6], mv[7]);
                        fmt = __builtin_bit_cast(bf16x8, mu_); }
#pragma unroll 1
                    for (int nt = 0; nt < 4; ++nt) {
                        const float ecn = *(const LAS float*)(scr + O_ECL + (16 * nt + c16) * 4);
                        const bf16x8 fb = (q4 < 2) ? *(const LAS bf16x8*)(scr + O_XB + (16 * nt + c16) * 32 + 16 * q4) : zf;
                        const f32x4 z4 = (f32x4){0.f, 0.f, 0.f, 0.f};
                        f32x4 gt[4], hm;
#pragma unroll
                        for (int mt2 = 0; mt2 < 4; ++mt2) gt[mt2] = __builtin_amdgcn_mfma_f32_16x16x32_bf16(fat[mt2], fb, z4, 0, 0, 0);
                        hm = __builtin_amdgcn_mfma_f32_16x16x32_bf16(fmt, fb, z4, 0, 0, 0);
#pragma unroll
                        for (int mt2 = 0; mt2 < 4; ++mt2)
#pragma unroll
                            for (int r_ = 0; r_ < 4; ++r_) gt[mt2][r_] *= ecn;
#pragma unroll
                        for (int r_ = 0; r_ < 4; ++r_) { if (4 * q4 + r_ == c16) gt[nt][r_] += ecn; hm[r_] = (hm[r_] + XV(O_XK, 4 * q4 + r_, 16 * nt + c16)) * ecn; }
#pragma unroll
                        for (int s2 = 0; s2 < 2; ++s2) { u32x4 o; o.x = pg8::cvt_pk_bf16(gt[2 * s2][0], gt[2 * s2][1]); o.y = pg8::cvt_pk_bf16(gt[2 * s2][2], gt[2 * s2][3]); o.z = pg8::cvt_pk_bf16(gt[2 * s2 + 1][0], gt[2 * s2 + 1][1]); o.w = pg8::cvt_pk_bf16(gt[2 * s2 + 1][2], gt[2 * s2 + 1][3]);
                            *(u32x4*)(opsb + (size_t)mt * OPB + (nt * 2 + s2) * 1024 + lane * 16) = o; }
                        *(u32x2*)(opsb + (size_t)mt * OPB + 10240 + nt * 512 + lane * 8) = (u32x2){pg8::cvt_pk_bf16(hm[0], hm[1]), pg8::cvt_pk_bf16(hm[2], hm[3])};
                    }
                }
                LFENCE();
#undef AT_A
#undef LFENCE
#undef SM_MUL
#undef XV
#undef SM_B
#undef SM_A
#undef SM_WR
                __syncthreads();
            }
#undef PREP_LOAD
        }
#undef PREP_ATILE
        __syncthreads();
        const int lane_b = pg8::lane_now();
        {
            const int lane = lane_b;
            const float lg_ = lng[64 * w + lane], lb_ = lnb[64 * w + lane];
            LAS unsigned char* vrow = lds + w * VWAVE + lane * VST;
            const bf16_t* pv = Pp + (size_t)m0 * INC + RWC + CW + 64 * w + lane;
            bf16_t raw[8], nraw[8];
#pragma unroll
            for (int s = 0; s < 8; ++s) raw[s] = pv[(size_t)s * INC];
            for (int sb = 0; sb < 16; ++sb) {
                if (sb + 1 < 16) {
#pragma unroll
                    for (int s = 0; s < 8; ++s) nraw[s] = pv[(size_t)((sb + 1) * 8 + s) * INC];
                }
                float vn[8];
#pragma unroll
                for (int s = 0; s < 8; ++s) {
                    const float z = fast_gelu(bf2f(raw[s]));
                    const float mean = red64(z) * (1.f / 64.f); const float d = z - mean;
                    const float var = red64(d * d) * (1.f / 64.f);
                    vn[s] = d * rsqrtf(var + 1e-5f) * lg_ + lb_;
                }
                u32x4 o; o.x = pg8::cvt_pk_bf16(vn[0], vn[1]); o.y = pg8::cvt_pk_bf16(vn[2], vn[3]); o.z = pg8::cvt_pk_bf16(vn[4], vn[5]); o.w = pg8::cvt_pk_bf16(vn[6], vn[7]);
                *(LAS u32x4*)(vrow + sb * 16) = o;
#pragma unroll
                for (int s = 0; s < 8; ++s) raw[s] = nraw[s];
            }
        }
        asm volatile("s_waitcnt lgkmcnt(0)" ::: "memory");
        {
            const int c16 = lane_b & 15, q4 = lane_b >> 4;
            const float* wsg = wsp + (size_t)w * 16384;
            const LAS unsigned char* vb = lds + w * VWAVE + 16 * q4;
            for (int mt = 0; mt < 8; ++mt) {
                f32x4 acc[4];
#pragma unroll
                for (int j = 0; j < 4; ++j) acc[j] = (f32x4){0.f, 0.f, 0.f, 0.f};
                const int t_a = 16 * mt + c16;
                uint2 pu[4]; float bias[4];
#pragma unroll
                for (int rr = 0; rr < 4; ++rr) { const int tl = 16 * mt + 4 * q4 + rr; pu[rr] = *(const uint2*)(Pp + (size_t)(m0 + tl) * INC + RWC + 64 * w + 4 * c16); bias[rr] = bsp[w * 128 + tl]; }
                f32x4 x0[4], x1[4];
#pragma unroll
                for (int ks = 0; ks < 4; ++ks) if (ks <= mt / 2) { const int s0 = 32 * ks + 8 * q4; x0[ks] = *(const f32x4*)(wsg + (size_t)t_a * 128 + s0); x1[ks] = *(const f32x4*)(wsg + (size_t)t_a * 128 + s0 + 4); }
#pragma unroll
                for (int ks = 0; ks < 4; ++ks) if (ks <= mt / 2) {
                    const int s0 = 32 * ks + 8 * q4;
                    float xv[8] = {x0[ks][0], x0[ks][1], x0[ks][2], x0[ks][3], x1[ks][0], x1[ks][1], x1[ks][2], x1[ks][3]};
#pragma unroll
                    for (int e = 0; e < 8; ++e) if (s0 + e > t_a) xv[e] = 0.f;
                    u32x4 au; au.x = pg8::cvt_pk_bf16(xv[0], xv[1]); au.y = pg8::cvt_pk_bf16(xv[2], xv[3]); au.z = pg8::cvt_pk_bf16(xv[4], xv[5]); au.w = pg8::cvt_pk_bf16(xv[6], xv[7]);
                    const bf16x8 af = __builtin_bit_cast(bf16x8, au);
#pragma unroll
                    for (int j = 0; j < 4; ++j) { const bf16x8 bfr = *(const LAS bf16x8*)(vb + (4 * c16 + j) * VST + ks * 64); acc[j] = __builtin_amdgcn_mfma_f32_16x16x32_bf16(af, bfr, acc[j], 0, 0, 0); }
                }
#pragma unroll
                for (int rr = 0; rr < 4; ++rr) {
                    const int m = m0 + 16 * mt + 4 * q4 + rr;
                    const float u0 = fast_gelu(pg8::bflo(pu[rr].x)), u1 = fast_gelu(pg8::bfhi(pu[rr].x)), u2 = fast_gelu(pg8::bflo(pu[rr].y)), u3 = fast_gelu(pg8::bfhi(pu[rr].y));
                    if constexpr (MRG_F8) *(unsigned*)((unsigned char*)O + (size_t)m * D + CW + 64 * w + 4 * c16) = (unsigned)pk4_fp8(u0 * (acc[0][rr] + bias[rr]) * OGM_SCALE, u1 * (acc[1][rr] + bias[rr]) * OGM_SCALE, u2 * (acc[2][rr] + bias[rr]) * OGM_SCALE, u3 * (acc[3][rr] + bias[rr]) * OGM_SCALE);
                    else { uint2 ov; ov.x = pg8::cvt_pk_bf16(u0 * (acc[0][rr] + bias[rr]), u1 * (acc[1][rr] + bias[rr])); ov.y = pg8::cvt_pk_bf16(u2 * (acc[2][rr] + bias[rr]), u3 * (acc[3][rr] + bias[rr]));
                    *(uint2*)(O + (size_t)m * D + CW + 64 * w + 4 * c16) = ov; }
                }
            }
        }
        __syncthreads();
    }
}

__device__ __forceinline__ void f_post(const Params& P, const Ctx& c) {
    const bf16_t* V = (const bf16_t*)(P.ws + WS_SCANV); const float* Y = (const float*)(P.ws + WS_Y); const float* Gb = (const float*)(P.ws + WS_G);
    const float* bonus = (const float*)(P.ws + WS_BONUS); const float *lg = P.in[15], *lb = P.in[16];
    bf16_t* O = (bf16_t*)(P.ws + WS_O);
    const int l16 = c.lane & 15, sub = c.lane >> 4;
    for (int it = c.gwave; it < NTOK * 2; it += c.nwaves) {
        const int m = it >> 1, h = (it & 1) * 4 + sub, col = h * 64 + 4 * l16;
        const unsigned ob = (unsigned)(m * CW + col) * 4u;
        const u32x2 yb_ = *(const u32x2*)((const char*)Y + (ob >> 1)), gb_ = *(const u32x2*)((const char*)Gb + (ob >> 1)), vb_ = *(const u32x2*)((const char*)V + (ob >> 1));
        const f32x4 yv = (f32x4){pg8::bflo(yb_[0]), pg8::bfhi(yb_[0]), pg8::bflo(yb_[1]), pg8::bfhi(yb_[1])}, gv = (f32x4){pg8::bflo(gb_[0]), pg8::bfhi(gb_[0]), pg8::bflo(gb_[1]), pg8::bfhi(gb_[1])};
        const f32x4 vv = (f32x4){pg8::bflo(vb_[0]), pg8::bfhi(vb_[0]), pg8::bflo(vb_[1]), pg8::bfhi(vb_[1])};
        const f32x4 lgv = *(const f32x4*)(lg + col), lbv = *(const f32x4*)(lb + col);
        const float bn = bonus[m * 8 + h];
        const float mean = red16((yv[0] + yv[1]) + (yv[2] + yv[3])) * (1.f / 64.f);
        const f32x4 d = yv - mean;
        const float var = red16((d[0] * d[0] + d[1] * d[1]) + (d[2] * d[2] + d[3] * d[3])) * (1.f / 64.f);
        const float rs = rsqrtf(var + 64e-5f);
        float o[4];
#pragma unroll
        for (int j = 0; j < 4; ++j) o[j] = (d[j] * rs * lgv[j] + lbv[j] + bn * vv[j]) * gv[j];
        if constexpr (MRG_F8) *(unsigned*)((unsigned char*)O + (size_t)m * D + col) = (unsigned)pk4_fp8(o[0] * ORW_SCALE, o[1] * ORW_SCALE, o[2] * ORW_SCALE, o[3] * ORW_SCALE);
        else { uint2 ov; ov.x = pg8::cvt_pk_bf16(o[0], o[1]); ov.y = pg8::cvt_pk_bf16(o[2], o[3]);
        *(uint2*)(O + (size_t)m * D + col) = ov; }
    }
}

__global__ void __launch_bounds__(NT) fwd_kernel(Params P) {
    cg::grid_group grid = cg::this_grid();
#define MKTID() ({ int l_; asm volatile("v_mbcnt_lo_u32_b32 %0, -1, 0\n\tv_mbcnt_hi_u32_b32 %0, -1, %0" : "=v"(l_)); const int t_ = (s_wave << 6) | l_; t_; })
#define MKCTX() ({ Ctx c_; const int t_ = MKTID(); c_.tid = t_; c_.gtid = (long)blockIdx.x * NT + t_; c_.gthreads = (long)gridDim.x * NT; c_.gwave = (int)(c_.gtid >> 6); c_.nwaves = (int)(c_.gthreads >> 6); c_.lane = t_ & 63; c_; })
    bf16_t* H = (bf16_t*)(P.ws + WS_H); bf16_t* Pp = (bf16_t*)(P.ws + WS_P);
    const float* mod = (const float*)(P.ws + WS_MOD);
    extern __shared__ __attribute__((aligned(16))) unsigned char lds_raw[];
    LAS unsigned char* lds = (LAS unsigned char*)lds_raw;
    const int s_wave = __builtin_amdgcn_readfirstlane(threadIdx.x >> 6);
    LAS float* scr = (LAS float*)(lds + s_wave * 16384);
    volatile LAS unsigned* bst = (volatile LAS unsigned*)(lds + 131072 + 16384 + 7168);
    if (threadIdx.x == 0) { bst[0] = 0u; bst[1] = 0u; }
    __syncthreads();
    const XcdBarrier xbar = xcd_barrier_post((unsigned*)(P.ws + WS_CTL), bst, (int)threadIdx.x);
#define GSYNC() xcd_barrier(xbar, MKTID())
#define PH(k) for (int rep_ = 0; rep_ < (((PROBE_MASK >> (k)) & 1) ? PROBE_N : 1); ++rep_)

    PH(0) { f_mod(P, lds, MKTID()); __syncthreads(); }
    PH(1) { transpose_small(P, scr, MKCTX()); __syncthreads(); }
    if (P.ws == nullptr) grid.sync();
    GSYNC();
    PH(2) n_norm<(PG_F8 ? 2 : 0), false>(P, MKCTX(), P.in[0], P.in[4], 0, 1);
    GSYNC();
    PH(3) {
        pg8::DenseSched S; S.init(NTOK, INC, D, gridDim.x, blockIdx.x, P.ws + WS_WTIN, PG_F8 ? 1 : 2);
        pg8::EpiP E{Pp, INC, P.ws + WS_GT};
        pg8::gemm_phase<pg8::EpiP, pg8::DenseSched, true, PG_F8>(lds, (const char*)H, D, S, E, MKTID());
    }
    GSYNC();
    PH(4) f_prep_gmlp(P, lds, MKTID());
    GSYNC();
    PH(5) {
        if (blockIdx.x < NB * 8) f_scan(P, lds, MKTID());
        else {
            Ctx c_ = MKCTX(); c_.gwave -= NB * 8 * (NT / 64); c_.nwaves -= NB * 8 * (NT / 64);
            transpose_moe(P, lds, s_wave, c_);
        }
    }
    GSYNC();
    PH(6) f_post(P, MKCTX());
    GSYNC();
    PH(8) {
        pg8::DenseSched S; S.init(NTOK, D, D, gridDim.x, blockIdx.x, P.ws + WS_WTBR, MRG_F8 ? 1 : 2);
        pg8::EpiMerge E{Pp, (bf16_t*)(P.ws + WS_Y), P.ws + WS_GT};
        pg8::gemm_phase<pg8::EpiMerge, pg8::DenseSched, true, MRG_F8>(lds, (const char*)(P.ws + WS_O), D, S, E, MKTID());
    }
    GSYNC();
    PH(9) {
        pg8::DenseSched S; S.init(NTOK, D, D, gridDim.x, blockIdx.x, P.ws + WS_WTOUT, OUT_F8 ? 1 : 2);
        pg8::EpiOut E{P.in[0], mod, (bf16_t*)(P.ws + WS_X1)};
        pg8::gemm_phase<pg8::EpiOut, pg8::DenseSched, true, OUT_F8>(lds, (const char*)(P.ws + WS_Y), D, S, E, MKTID());
    }
    GSYNC();
    PH(10) n_norm<(MOE1_F8 ? 1 : 0), true>(P, MKCTX(), P.ws + WS_X1, P.in[24], 3, 4);
    GSYNC();
    PH(11) {
        const int half = (int)gridDim.x >> 1;
        if ((int)blockIdx.x < half) {
            pg8::DenseSched S; S.init(NTOK, NE, D, half, blockIdx.x, P.ws + WS_WTRS);
            pg8::EpiRouter E{(float*)(P.ws + WS_G)};
            pg8::gemm_phase<pg8::EpiRouter, pg8::DenseSched, true>(lds, (const char*)H, D, S, E, MKTID());
        } else {
            pg8::DenseSched S; S.init(NTOK, 2 * ED, D, half, (int)blockIdx.x - half, P.ws + WS_WTRS + 512 * 1024, 1);
            pg8::EpiShared E{(bf16_t*)(P.ws + WS_ACTSH)};
            pg8::gemm_phase<pg8::EpiShared, pg8::DenseSched, true, true>(lds, (const char*)(P.ws + WS_H2F8), D, S, E, MKTID());
        }
    }
    GSYNC();
    PH(12) f_topk(P, (int*)(lds_raw + 131072 + 16384), MKTID());
    GSYNC();
    PH(13) f_route2(P, (int*)(lds_raw + 131072 + 16384), MKTID());
    GSYNC();
    PH(14) {
        const int* tile_e = (const int*)(P.ws + WS_TILE); const int ntiles = __builtin_amdgcn_readfirstlane(tile_e[6144]);
        pg8::MoeSched1 S{(const int*)(P.ws + WS_ROWTOK), tile_e, ntiles * 2, (int)gridDim.x, (int)blockIdx.x, (const char*)(P.ws + WS_WTGU)};
        pg8::EpiMoe1 E{(bf16_t*)(P.ws + WS_ACTP)};
        pg8::gemm_phase<pg8::EpiMoe1, pg8::MoeSched1, true, MOE1_F8>(lds, MOE1_F8 ? (const char*)(P.ws + WS_H2F8) : (const char*)H, D, S, E, MKTID());
    }
    GSYNC();
    PH(15) {
        const int* tile_e = (const int*)(P.ws + WS_TILE); const int ntiles = __builtin_amdgcn_readfirstlane(tile_e[6144]);
        pg8::MoeSched2 S{tile_e, ntiles * 4, (int)gridDim.x, (int)blockIdx.x, (const char*)(P.ws + WS_WTDN)};
        pg8::EpiMoe2 E{(bf16_t*)(P.ws + WS_YS), (const float*)(P.ws + WS_ROWW), P.ws + WS_G + (size_t)blockIdx.x * 1024};
        pg8::gemm_phase<pg8::EpiMoe2, pg8::MoeSched2, true, true>(lds, (const char*)(P.ws + WS_ACTP), ED, S, E, MKTID());
    }
    PH(16) {
        pg8::DenseSched S2; S2.init(NTOK, D, ED, gridDim.x, blockIdx.x, P.ws + WS_WTSHD);
        pg8::EpiYsh E2{(bf16_t*)(P.ws + WS_YSH)};
        pg8::gemm_phase<pg8::EpiYsh, pg8::DenseSched, true>(lds, (const char*)(P.ws + WS_ACTSH), ED, S2, E2, MKTID());
    }
    GSYNC();
    f_final(P, MKCTX());
}

extern "C" void kernel_launch(void* const* d_in, const int* in_sizes, int n_in, void* d_out, int out_size, void* d_ws, size_t ws_size, hipStream_t stream) {
    static int grid_blocks = 0;
    if (!grid_blocks) {
        int dev = 0, cus = 0, per_cu = 0;
        hipGetDevice(&dev);
        hipDeviceGetAttribute(&cus, hipDeviceAttributeMultiprocessorCount, dev);
        if (hipFuncSetAttribute((const void*)fwd_kernel, hipFuncAttributeMaxDynamicSharedMemorySize, LDS_BYTES) != hipSuccess) fprintf(stderr, "kernel_launch: hipFuncSetAttribute failed\n");
        if (hipOccupancyMaxActiveBlocksPerMultiprocessor(&per_cu, fwd_kernel, NT, LDS_BYTES) != hipSuccess || per_cu < 1) { fprintf(stderr, "kernel_launch: occupancy query says %d\n", per_cu); per_cu = 1; }
        (void)hipGetLastError();
        grid_blocks = cus;
        if (n_in != 34 || ws_size < WS_END) fprintf(stderr, "kernel_launch: unexpected n_in %d or ws_size %zu\n", n_in, ws_size);
    }
    (void)hipMemsetAsync((char*)d_ws + WS_CTL, 0, 65536, stream);
    Params p{};
    for (int i = 0; i < 34; ++i) p.in[i] = (const float*)d_in[i];
    p.out = (float*)d_out; p.ws = (unsigned char*)d_ws;
    void* args[] = {&p};
    hipError_t e = hipLaunchCooperativeKernel((void*)fwd_kernel, dim3(grid_blocks), dim3(NT), args, LDS_BYTES, stream);
    if (e != hipSuccess) fprintf(stderr, "cooperative launch failed: %s (grid %d)\n", hipGetErrorString(e), grid_blocks);
}
```
